# Optimizing an MI355X kernel written in HIP

```python
import jax, jax.numpy as jnp
from jax import lax
import numpy as np

D_MODEL = 2048
BATCH = 4
SEQ = 4096
DEPTH = 1
DEC_BATCH = 2
DEC_SEQ = 16384
PAST_LEN = 128

HEAD_DIM = 128
N_Q_HEADS = 16
N_KV_HEADS = 4
Q_PER_KV = N_Q_HEADS // N_KV_HEADS
ATTN_WIDTH = N_Q_HEADS * HEAD_DIM
KV_WIDTH = N_KV_HEADS * HEAD_DIM
WINDOW = 128
BLOCK = 128
CHUNK = 128
N_SGU_GROUPS = 16
SGU_WIDTH = D_MODEL
SGU_GROUP_DIM = SGU_WIDTH // N_SGU_GROUPS
N_EXPERTS = 16
CAPACITY_FACTOR = 2
D_FF_EXPERT = 2816
NORM_EPS = 1e-6
IN_SPLITS = (ATTN_WIDTH, KV_WIDTH, KV_WIDTH, SGU_WIDTH, SGU_WIDTH, D_MODEL, D_MODEL)
IN_WIDTH = sum(IN_SPLITS)

kernel_name = "hybrid_sgu_swa_ec_moe_encoder"


def rmsnorm(x, g):
    xf = x.astype(jnp.float32)
    y = xf * lax.rsqrt(jnp.mean(xf * xf, axis=-1, keepdims=True) + NORM_EPS)
    return (y * g.astype(jnp.float32)).astype(x.dtype)


def layernorm(x, g, b):
    xf = x.astype(jnp.float32)
    mu = jnp.mean(xf, axis=-1, keepdims=True)
    var = jnp.mean(jnp.square(xf - mu), axis=-1, keepdims=True)
    return (xf - mu) * lax.rsqrt(var + NORM_EPS) * g.astype(jnp.float32) + b.astype(jnp.float32)


def alibi_slopes(n):
    return jnp.exp2(-8.0 * jnp.arange(1, n + 1, dtype=jnp.float32) / n)


def windowed_attention(q, k, v, sink):
    B, S = q.shape[0], q.shape[1]
    nb = S // BLOCK
    qb = q.reshape(B, nb, BLOCK, N_KV_HEADS, Q_PER_KV, HEAD_DIM)
    pad = ((0, 0), (BLOCK, BLOCK), (0, 0), (0, 0))
    kp = jnp.pad(k, pad).reshape(B, nb + 2, BLOCK, N_KV_HEADS, HEAD_DIM)
    vp = jnp.pad(v, pad).reshape(B, nb + 2, BLOCK, N_KV_HEADS, HEAD_DIM)
    kb = jnp.concatenate([kp[:, :-2], kp[:, 1:-1], kp[:, 2:]], axis=2)
    vb = jnp.concatenate([vp[:, :-2], vp[:, 1:-1], vp[:, 2:]], axis=2)
    s = jnp.einsum('bnqhgd,bnkhd->bnhgqk', qb, kb, preferred_element_type=jnp.float32)
    qi = jnp.arange(BLOCK)[:, None]
    kj = jnp.arange(3 * BLOCK)[None, :]
    rel = kj - BLOCK - qi
    kpos = jnp.arange(nb)[:, None] * BLOCK - BLOCK + jnp.arange(3 * BLOCK)[None, :]
    valid = (jnp.abs(rel) <= WINDOW)[None] & ((kpos >= 0) & (kpos < S))[:, None, :]
    slopes = alibi_slopes(N_Q_HEADS).reshape(N_KV_HEADS, Q_PER_KV)
    bias = -slopes[:, :, None, None] * jnp.abs(rel).astype(jnp.float32)[None, None]
    s = jnp.where(valid[None, :, None, None], s + bias[None, None], -jnp.inf)
    sink_hg = sink.astype(jnp.float32).reshape(N_KV_HEADS, Q_PER_KV)[None, None, :, :, None]
    m = jnp.maximum(jnp.max(s, axis=-1), sink_hg)
    p = jnp.exp(s - m[..., None])
    denom = jnp.sum(p, axis=-1) + jnp.exp(sink_hg - m)
    p = p / denom[..., None]
    o = jnp.einsum('bnhgqk,bnkhd->bnqhgd', p.astype(v.dtype), vb)
    return o.reshape(B, S, ATTN_WIDTH)


def spatial_gating(u, v, ln_g, ln_b, w_s, b_s):
    B, S = u.shape[0], u.shape[1]
    vn = layernorm(v, ln_g, ln_b).reshape(B, S // CHUNK, CHUNK, N_SGU_GROUPS, SGU_GROUP_DIM)
    mixed = jnp.einsum('gts,bnsgc->bntgc', w_s.astype(jnp.float32), vn)
    mixed = mixed + b_s.astype(jnp.float32).T[None, None, :, :, None]
    return u * mixed.reshape(B, S, SGU_WIDTH).astype(u.dtype)


def token_mixer(h, w_in, q_norm_g, k_norm_g, attn_sink, sgu_ln_g, sgu_ln_b, sgu_w, sgu_b,
                w_o_attn, w_o_sgu, w_out):
    B, S, _ = h.shape
    z = h @ w_in
    idx = list(np.cumsum(IN_SPLITS)[:-1])
    q, k, v, u, vg, ga, gs = jnp.split(z, idx, axis=-1)
    q = rmsnorm(q.reshape(B, S, N_Q_HEADS, HEAD_DIM), q_norm_g) * (HEAD_DIM ** -0.5)
    k = rmsnorm(k.reshape(B, S, N_KV_HEADS, HEAD_DIM), k_norm_g)
    v = v.reshape(B, S, N_KV_HEADS, HEAD_DIM)
    attn = windowed_attention(q, k, v, attn_sink) @ w_o_attn
    sgu = spatial_gating(jax.nn.gelu(u), jax.nn.gelu(vg), sgu_ln_g, sgu_ln_b, sgu_w, sgu_b) @ w_o_sgu
    merged = jax.nn.sigmoid(ga) * attn + jax.nn.sigmoid(gs) * sgu
    return merged @ w_out


def expert_choice_ffn(h, w_router, w_gate, w_up, w_down):
    B, S, D = h.shape
    T = B * S
    C = CAPACITY_FACTOR * T // N_EXPERTS
    xt = h.reshape(T, D)
    aff = jax.nn.softmax((xt @ w_router).astype(jnp.float32), axis=-1)
    top_w, top_idx = lax.top_k(aff.T, C)
    xe = xt[top_idx]
    g = jnp.einsum('ecd,edf->ecf', xe, w_gate)
    up = jnp.einsum('ecd,edf->ecf', xe, w_up)
    y = jnp.einsum('ecf,efd->ecd', jax.nn.silu(g) * up, w_down)
    y = y * top_w[..., None].astype(y.dtype)
    out = jnp.zeros((T, D), y.dtype).at[top_idx.reshape(-1)].add(y.reshape(-1, D))
    return out.reshape(B, S, D)


def trunk(x, c, weights):
    (w_ada, b_ada, norm1_g, norm2_g, w_in, q_norm_g, k_norm_g, attn_sink, sgu_ln_g, sgu_ln_b,
     sgu_w, sgu_b, w_o_attn, w_o_sgu, w_out, w_router, w_gate, w_up, w_down) = weights
    for l in range(DEPTH):
        mod = jax.nn.silu(c) @ w_ada[l] + b_ada[l]
        sh1, sc1, g1, sh2, sc2, g2 = jnp.split(mod[:, None, :], 6, axis=-1)
        h = rmsnorm(x, norm1_g[l]) * (1 + sc1) + sh1
        x = x + g1 * token_mixer(h, w_in[l], q_norm_g[l], k_norm_g[l], attn_sink[l], sgu_ln_g[l],
                                 sgu_ln_b[l], sgu_w[l], sgu_b[l], w_o_attn[l], w_o_sgu[l], w_out[l])
        h = rmsnorm(x, norm2_g[l]) * (1 + sc2) + sh2
        x = x + g2 * expert_choice_ffn(h, w_router[l], w_gate[l], w_up[l], w_down[l])
    return x


def setup_inputs(seed: int = 0) -> dict:
    key = jax.random.key(seed)
    ks = jax.random.split(key, 24)
    f32 = jnp.float32
    nrm = lambda k, shape, s: jax.random.normal(k, shape, f32) * s
    L, D = DEPTH, D_MODEL
    return {
        "x_prompt": nrm(ks[0], (BATCH, SEQ, D), 1.0),
        "x_sample": nrm(ks[1], (DEC_BATCH, DEC_SEQ, D), 1.0),
        "c_prompt": nrm(ks[2], (BATCH, D), 1.0),
        "c_sample": nrm(ks[3], (DEC_BATCH, D), 1.0),
        "w_ada": nrm(ks[4], (L, D, 6 * D), 0.3 * D ** -0.5),
        "b_ada": nrm(ks[5], (L, 6 * D), 0.02),
        "norm1_g": 1.0 + nrm(ks[6], (L, D), 0.02),
        "norm2_g": 1.0 + nrm(ks[7], (L, D), 0.02),
        "w_in": nrm(ks[8], (L, D, IN_WIDTH), D ** -0.5),
        "q_norm_g": 1.0 + nrm(ks[9], (L, HEAD_DIM), 0.02),
        "k_norm_g": 1.0 + nrm(ks[10], (L, HEAD_DIM), 0.02),
        "attn_sink": nrm(ks[11], (L, N_Q_HEADS), 0.5),
        "sgu_ln_g": 1.0 + nrm(ks[12], (L, SGU_WIDTH), 0.02),
        "sgu_ln_b": nrm(ks[13], (L, SGU_WIDTH), 0.02),
        "sgu_w": nrm(ks[14], (L, N_SGU_GROUPS, CHUNK, CHUNK), CHUNK ** -0.5),
        "sgu_b": 1.0 + nrm(ks[15], (L, N_SGU_GROUPS, CHUNK), 0.02),
        "w_o_attn": nrm(ks[16], (L, ATTN_WIDTH, D), ATTN_WIDTH ** -0.5),
        "w_o_sgu": nrm(ks[17], (L, SGU_WIDTH, D), SGU_WIDTH ** -0.5),
        "w_out": nrm(ks[18], (L, D, D), D ** -0.5),
        "w_router": nrm(ks[19], (L, D, N_EXPERTS), D ** -0.5),
        "w_gate": nrm(ks[20], (L, N_EXPERTS, D, D_FF_EXPERT), D ** -0.5),
        "w_up": nrm(ks[21], (L, N_EXPERTS, D, D_FF_EXPERT), D ** -0.5),
        "w_down": nrm(ks[22], (L, N_EXPERTS, D_FF_EXPERT, D), D_FF_EXPERT ** -0.5),
    }


def reference(x_prompt, x_sample, c_prompt, c_sample, w_ada, b_ada, norm1_g, norm2_g, w_in,
              q_norm_g, k_norm_g, attn_sink, sgu_ln_g, sgu_ln_b, sgu_w, sgu_b, w_o_attn, w_o_sgu,
              w_out, w_router, w_gate, w_up, w_down):
    weights = (w_ada, b_ada, norm1_g, norm2_g, w_in, q_norm_g, k_norm_g, attn_sink, sgu_ln_g,
               sgu_ln_b, sgu_w, sgu_b, w_o_attn, w_o_sgu, w_out, w_router, w_gate, w_up, w_down)
    y_prompt = trunk(x_prompt, c_prompt, weights)
    y_sample = trunk(x_sample, c_sample, weights)
    return (y_prompt, y_sample)
```

```cpp
#include <hip/hip_runtime.h>
#include <cstdio>
#include <cstdint>

#ifndef MK_PER_PHASE
#define MK_PER_PHASE 0
#endif
#ifndef PROBE_MASK
#define PROBE_MASK 0
#endif
#ifndef DBG_WHICH
#define DBG_WHICH 0
#endif
#ifndef DBG_NPH
#define DBG_NPH 12
#endif

namespace pg8 {
#define PG8_LAS __attribute__((address_space(3)))
typedef unsigned short bf16_t;
typedef short bf16x8 __attribute__((ext_vector_type(8)));
typedef float f32x4 __attribute__((ext_vector_type(4)));
typedef unsigned u32x4 __attribute__((ext_vector_type(4)));
constexpr int BM = 256, BK = 64, HALF = 128, HTB = HALF * BK * 2, STAGE_BYTES = 8 * HTB, NXCD = 8, WGM = 4;

__host__ __device__ __forceinline__ int lds_byte(int r, int c) { const int st = (r >> 4) * 2 + (c >> 5), rr = r & 15, cc = c & 31, ob = rr * 64 + cc * 2; return st * 1024 + (ob ^ (((ob >> 9) & 1) << 5)); }
__host__ __device__ __forceinline__ void stage_rc(int b, int& R, int& C) { const int st = b / 1024, sb = b % 1024, swz = sb ^ (((sb >> 9) & 1) << 5); R = (st >> 1) * 16 + swz / 64; C = (st & 1) * 32 + (swz % 64) / 2; }
__host__ __device__ __forceinline__ int perm32(int rho) { const int n = rho >> 4, i = rho & 15; return 8 * (i >> 2) + 4 * n + (i & 3); }

struct Unit { const char* a; const char* b; const int* idx; int pm, pn, aux; };

__device__ __forceinline__ void tile_of(int wgid, int nM, int nN, int& pm, int& pn) {
    const int nwg = nM * nN; { const int q = nwg / NXCD, r = nwg % NXCD, xcd = wgid % NXCD, off = wgid / NXCD; wgid = (xcd < r ? xcd * (q + 1) : r * (q + 1) + (xcd - r) * q) + off; }
    const int nig = WGM * nN, gid = wgid / nig, fm = gid * WGM, gsz = (nM - fm) < WGM ? (nM - fm) : WGM;
    pm = fm + ((wgid % nig) % gsz); pn = (wgid % nig) / gsz;
}

__device__ __forceinline__ unsigned cvt_pk_bf16(float lo, float hi) { unsigned r; asm volatile("s_nop 1\n\tv_cvt_pk_bf16_f32 %0, %1, %2" : "=v"(r) : "v"(lo), "v"(hi)); return r; }
__device__ __forceinline__ float bf_lo(unsigned u) { return __uint_as_float(u << 16); }
__device__ __forceinline__ float bf_hi(unsigned u) { return __uint_as_float(u & 0xffff0000u); }

typedef int i32x4 __attribute__((ext_vector_type(4)));
typedef int i32x8 __attribute__((ext_vector_type(8)));
template <int MODE> struct AccT { typedef f32x4 type; };
template <> struct AccT<1> { typedef i32x4 type; };
template <class Epi, class Sched, bool ALIGN_EPI = false, bool SP2 = false, int MODE = 0, bool GATHER = false>
__device__ __forceinline__ void gemm_phase(PG8_LAS unsigned char* lds, const int PA, const int PB, const int nt, const Sched& S, const Epi& E, const int wid_in) {
    const int tid = threadIdx.x, wid = __builtin_amdgcn_readfirstlane(tid >> 6), lane = tid & 63, wr = wid >> 2, wc = wid & 3, fr = lane & 15, fq = lane >> 4;
    typedef typename AccT<MODE>::type acc_t;
    unsigned voffA[2], voffB[2];
#pragma unroll
    for (int i = 0; i < 2; ++i) { int R, C; stage_rc(tid * 16 + i * 8192, R, C); const int Rb = (R & ~31) + perm32(R & 31);
        voffA[i] = (unsigned)(R * PA + C * 2); voffB[i] = (unsigned)(Rb * PB + C * 2); }
    unsigned vgC[2][2], vgN[2][2]; int gR[2], gC2[2];
    if constexpr (GATHER) { static_assert(SP2, "GATHER is written for the SP2 loop");
#pragma unroll
        for (int i = 0; i < 2; ++i) { int R, C; stage_rc(tid * 16 + i * 8192, R, C); gR[i] = R; gC2[i] = C * 2; } }
    PG8_LAS unsigned char* idxbuf = lds + 131072 + 4096;
#define PG8_IDX_DMA(ptr, slot) do { if (wid == 0) __builtin_amdgcn_global_load_lds((const unsigned*)((const char*)(ptr) + lane * 16), (PG8_LAS unsigned*)(idxbuf + (slot) * 1024), 16, 0, 0); } while (0)
#define PG8_IDX_READ(dst, slot) do { _Pragma("unroll") for (int h_ = 0; h_ < 2; ++h_) _Pragma("unroll") for (int i_ = 0; i_ < 2; ++i_) \
        dst[h_][i_] = (unsigned)(*(const PG8_LAS int*)(idxbuf + (slot) * 1024 + (h_ * 128 + gR[i_]) * 4)) * (unsigned)PA + (unsigned)gC2[i_]; } while (0)
    const size_t kstep = (size_t)(BK * 2);
    const size_t hstepA = (size_t)HALF * PA, hstepB = (size_t)HALF * PB;
    const unsigned ldsw = (unsigned)wid * 1024u;
    const int aoff = lds_byte(wr * 64 + fr, fq * 8), boff = lds_byte(wc * 32 + fr, fq * 8);
#define PG8_SA(b, h) (((b) * 2 + (h)) * HTB)
#define PG8_SB(b, h) ((4 + (b) * 2 + (h)) * HTB)
#define PG8_STAGE(bufoff, gbase, voff) do { _Pragma("unroll") for (int _i = 0; _i < 2; ++_i) \
        __builtin_amdgcn_global_load_lds((const unsigned*)((const char*)(gbase) + (voff)[_i]), (PG8_LAS unsigned*)(lds + (bufoff) + ldsw + _i * 8192), 16, 0, 0); } while (0)
#define PG8_STAGE_A(b, h, kptr, NXT) do { if constexpr (GATHER) { _Pragma("unroll") for (int _i = 0; _i < 2; ++_i) { const unsigned vo_ = (NXT) ? vgN[h][_i] : vgC[h][_i]; \
        __builtin_amdgcn_global_load_lds((const unsigned*)((const char*)(kptr) + vo_), (PG8_LAS unsigned*)(lds + PG8_SA(b, h) + ldsw + _i * 8192), 16, 0, 0); } } \
        else PG8_STAGE(PG8_SA(b, h), (kptr) + (h) * hstepA, voffA); } while (0)
#define PG8_LDA(dst, b, h) do { _Pragma("unroll") for (int m = 0; m < 4; ++m) { if constexpr (MODE == 2) { const i32x4 lo_ = *(const PG8_LAS i32x4*)(lds + PG8_SA(b, h) + aoff + m * 2048), hi_ = *(const PG8_LAS i32x4*)(lds + PG8_SA(b, h) + aoff + m * 2048 + 1024); \
            dst##8[m] = __builtin_shufflevector(lo_, hi_, 0, 1, 2, 3, 4, 5, 6, 7); } else { _Pragma("unroll") for (int k = 0; k < 2; ++k) dst[m][k] = *(const PG8_LAS bf16x8*)(lds + PG8_SA(b, h) + aoff + m * 2048 + k * 1024); } } } while (0)
#define PG8_LDB(dst, b, h) do { _Pragma("unroll") for (int n = 0; n < 2; ++n) { if constexpr (MODE == 2) { const i32x4 lo_ = *(const PG8_LAS i32x4*)(lds + PG8_SB(b, h) + boff + n * 2048), hi_ = *(const PG8_LAS i32x4*)(lds + PG8_SB(b, h) + boff + n * 2048 + 1024); \
            dst##8[n] = __builtin_shufflevector(lo_, hi_, 0, 1, 2, 3, 4, 5, 6, 7); } else { _Pragma("unroll") for (int k = 0; k < 2; ++k) dst[n][k] = *(const PG8_LAS bf16x8*)(lds + PG8_SB(b, h) + boff + n * 2048 + k * 1024); } } } while (0)
#define PG8_MMA(ai, bj, At, Bt) do { __builtin_amdgcn_s_setprio(1); _Pragma("unroll") for (int m = 0; m < 4; ++m) _Pragma("unroll") for (int n = 0; n < 2; ++n) { \
        if constexpr (MODE == 2) { asm volatile("v_mfma_scale_f32_16x16x128_f8f6f4 %0, %1, %2, %0, %3, %3 op_sel_hi:[0,0,0]" : "+v"(acc[ai][bj][m][n]) : "v"(Bt##8[n]), "v"(At##8[m]), "v"(sc127)); } \
        else { _Pragma("unroll") for (int k = 0; k < 2; ++k) { \
          if constexpr (MODE == 1) acc[ai][bj][m][n] = __builtin_amdgcn_mfma_i32_16x16x64_i8(__builtin_bit_cast(i32x4, Bt[n][k]), __builtin_bit_cast(i32x4, At[m][k]), acc[ai][bj][m][n], 0, 0, 0); \
          else acc[ai][bj][m][n] = __builtin_amdgcn_mfma_f32_16x16x32_bf16(Bt[n][k], At[m][k], acc[ai][bj][m][n], 0, 0, 0); } } } __builtin_amdgcn_s_setprio(0); } while (0)
#define PG8_WAIT_V(n) asm volatile("s_waitcnt vmcnt(" #n ")" ::: "memory")
#define PG8_WAIT_L(n) asm volatile("s_waitcnt lgkmcnt(" #n ")" ::: "memory")
#define PG8_BAR __builtin_amdgcn_s_barrier()
#define PG8_SCHED __builtin_amdgcn_sched_barrier(0)
    Unit cur, nxt; int ui = 0;
    if (!S.next(0, cur)) return;
    acc_t acc[2][2][4][2];
#pragma unroll
    for (int a = 0; a < 2; ++a)
#pragma unroll
        for (int b = 0; b < 2; ++b)
#pragma unroll
            for (int m = 0; m < 4; ++m)
#pragma unroll
                for (int n = 0; n < 2; ++n) acc[a][b][m][n] = (acc_t){0, 0, 0, 0};
    const int sc127 = 0x7F7F7F7F;
    bf16x8 At[4][2], B0[2][2], B1[2][2]; i32x8 At8[4], B08[2], B18[2];
    const char* cA = cur.a; const char* cB = cur.b;
    if constexpr (SP2) {
        if constexpr (GATHER) { PG8_IDX_DMA(cur.idx, 0); PG8_WAIT_V(0); __syncthreads(); PG8_IDX_READ(vgC, 0); PG8_WAIT_L(0);
#pragma unroll
            for (int h_ = 0; h_ < 2; ++h_) { vgN[h_][0] = vgC[h_][0]; vgN[h_][1] = vgC[h_][1]; } }
        PG8_STAGE(PG8_SB(0, 0), cB, voffB); PG8_STAGE(PG8_SB(0, 1), cB + hstepB, voffB); PG8_STAGE_A(0, 0, cA, false); PG8_STAGE_A(0, 1, cA, false);
        if (wr == 1) PG8_BAR;
        PG8_WAIT_V(2); PG8_BAR;
        PG8_STAGE(PG8_SB(1, 0), cB + kstep, voffB); PG8_STAGE_A(1, 0, cA + kstep, false); PG8_STAGE(PG8_SB(1, 1), cB + hstepB + kstep, voffB);
        PG8_WAIT_V(6); PG8_BAR;
    } else {
        PG8_STAGE(PG8_SB(0, 0), cB, voffB); PG8_STAGE(PG8_SA(0, 0), cA, voffA); PG8_STAGE(PG8_SB(0, 1), cB + hstepB, voffB); PG8_STAGE(PG8_SA(0, 1), cA + hstepA, voffA);
        if (wr == 1) PG8_BAR;
        PG8_WAIT_V(4); PG8_BAR;
        PG8_STAGE(PG8_SB(1, 0), cB + kstep, voffB); PG8_STAGE(PG8_SA(1, 0), cA + kstep, voffA); PG8_STAGE(PG8_SB(1, 1), cB + hstepB + kstep, voffB);
        PG8_WAIT_V(6); PG8_BAR;
    }
    for (;;) {
        const bool has_next = S.next(ui + 1, nxt);
        const char* nA = has_next ? nxt.a : cA; const char* nB = has_next ? nxt.b : cB;
        if constexpr (GATHER) { if (has_next) PG8_IDX_DMA(nxt.idx, (ui + 1) & 1); }
        for (int t = 0; t < nt; t += 2) {
            const bool last = (t == nt - 2);
            const char* a1 = cA + (size_t)(t + 1) * kstep;
            const char* a2 = last ? nA : cA + (size_t)(t + 2) * kstep; const char* b2 = last ? nB : cB + (size_t)(t + 2) * kstep;
            const char* a3 = a2 + kstep; const char* b3 = b2 + kstep;
            if constexpr (SP2) {
            if constexpr (GATHER) { if (t == 4 && has_next) PG8_IDX_READ(vgN, (ui + 1) & 1); }
            PG8_LDB(B0, 0, 0); PG8_LDB(B1, 0, 1); PG8_SCHED; PG8_LDA(At, 0, 0); PG8_STAGE_A(1, 1, a1, false);
            PG8_WAIT_V(8); PG8_WAIT_L(0); PG8_BAR; PG8_MMA(0, 0, At, B0); PG8_MMA(0, 1, At, B1); PG8_BAR; PG8_SCHED;
            PG8_LDA(At, 0, 1); PG8_STAGE(PG8_SB(0, 0), b2, voffB); PG8_STAGE(PG8_SB(0, 1), b2 + hstepB, voffB); PG8_STAGE_A(0, 0, a2, last);
            PG8_WAIT_V(8); PG8_WAIT_L(0); PG8_BAR; PG8_MMA(1, 0, At, B0); PG8_MMA(1, 1, At, B1); PG8_BAR; PG8_SCHED;
            PG8_LDB(B0, 1, 0); PG8_LDB(B1, 1, 1); PG8_SCHED; PG8_LDA(At, 1, 0); PG8_STAGE_A(0, 1, a2, last);
            PG8_WAIT_V(8); PG8_WAIT_L(0); PG8_BAR; PG8_MMA(0, 0, At, B0); PG8_MMA(0, 1, At, B1); PG8_BAR; PG8_SCHED;
            PG8_LDA(At, 1, 1); PG8_STAGE(PG8_SB(1, 0), b3, voffB); PG8_STAGE(PG8_SB(1, 1), b3 + hstepB, voffB); PG8_STAGE_A(1, 0, a3, last);
            PG8_WAIT_V(8); PG8_WAIT_L(0); PG8_BAR; PG8_MMA(1, 0, At, B0); PG8_MMA(1, 1, At, B1); PG8_BAR; PG8_SCHED;
            } else {
            PG8_LDB(B0, 0, 0); PG8_SCHED; PG8_LDA(At, 0, 0); PG8_STAGE(PG8_SA(1, 1), a1 + hstepA, voffA);
            PG8_WAIT_L(8); PG8_BAR; PG8_WAIT_L(0); PG8_MMA(0, 0, At, B0); PG8_BAR; PG8_SCHED;
            PG8_LDB(B1, 0, 1); PG8_STAGE(PG8_SB(0, 0), b2, voffB);
            PG8_BAR; PG8_WAIT_L(0); PG8_MMA(0, 1, At, B1); PG8_BAR;
            PG8_LDA(At, 0, 1); PG8_STAGE(PG8_SA(0, 0), a2, voffA);
            PG8_BAR; PG8_WAIT_L(0); PG8_MMA(1, 0, At, B0); PG8_BAR; PG8_SCHED;
            PG8_STAGE(PG8_SB(0, 1), b2 + hstepB, voffB);
            PG8_WAIT_V(6); PG8_BAR; PG8_MMA(1, 1, At, B1); PG8_BAR;
            PG8_LDB(B0, 1, 0); PG8_SCHED; PG8_LDA(At, 1, 0); PG8_STAGE(PG8_SA(0, 1), a2 + hstepA, voffA);
            PG8_WAIT_L(8); PG8_BAR; PG8_WAIT_L(0); PG8_MMA(0, 0, At, B0); PG8_BAR; PG8_SCHED;
            PG8_LDB(B1, 1, 1); PG8_STAGE(PG8_SB(1, 0), b3, voffB);
            PG8_BAR; PG8_WAIT_L(0); PG8_MMA(0, 1, At, B1); PG8_BAR;
            PG8_LDA(At, 1, 1); PG8_STAGE(PG8_SA(1, 0), a3, voffA);
            PG8_BAR; PG8_WAIT_L(0); PG8_MMA(1, 0, At, B0); PG8_BAR; PG8_SCHED;
            PG8_STAGE(PG8_SB(1, 1), b3 + hstepB, voffB);
            PG8_WAIT_V(6); PG8_BAR; PG8_MMA(1, 1, At, B1); PG8_BAR;
            }
        }
        if constexpr (ALIGN_EPI) { if (wr == 0) PG8_BAR; }
        E(acc, cur, wr, wc, fr, fq);
        if (!has_next) break;
#pragma unroll
        for (int a = 0; a < 2; ++a)
#pragma unroll
            for (int b = 0; b < 2; ++b)
#pragma unroll
                for (int m = 0; m < 4; ++m)
#pragma unroll
                    for (int n = 0; n < 2; ++n) acc[a][b][m][n] = (acc_t){0, 0, 0, 0};
        cur = nxt; cA = nA; cB = nB; ++ui;
        if constexpr (GATHER) {
#pragma unroll
            for (int h_ = 0; h_ < 2; ++h_) { vgC[h_][0] = vgN[h_][0]; vgC[h_][1] = vgN[h_][1]; } }
        if constexpr (ALIGN_EPI) { if (wr == 1) PG8_BAR; }
    }
    PG8_WAIT_V(0);
    if constexpr (!ALIGN_EPI) { if (wr == 0) PG8_BAR; }
    PG8_BAR;
#undef PG8_SA
#undef PG8_SB
#undef PG8_STAGE
#undef PG8_STAGE_A
#undef PG8_IDX_DMA
#undef PG8_IDX_READ
#undef PG8_LDA
#undef PG8_LDB
#undef PG8_MMA
#undef PG8_WAIT_V
#undef PG8_WAIT_L
#undef PG8_BAR
#undef PG8_SCHED
}
}

constexpr int D = 2048, TP = 16384, TS = 32768, M = TP + TS, NSEQ = 6;
constexpr int IN_W = 11264, KVW = 512, NE = 16, FF = 2816, CAP_P = TP / 8, CAP_S = TS / 8, NSLOT = NE * (CAP_P + CAP_S);
constexpr int MODW = 6 * D, ADA_KC = 8;
constexpr float NORM_EPS = 1e-6f;
constexpr int NWAVES = 8, NPHASE = 12;

constexpr size_t MiB = 1u << 20;
constexpr size_t WS_CTL = 0, CTL_ZERO_BYTES = 1 * MiB;
constexpr size_t WS_MODP = 1 * MiB;
constexpr size_t WS_MOD = 3 * MiB + 512 * 1024;
constexpr size_t WS_WIN = 4 * MiB;
constexpr size_t WS_WOA = 48 * MiB, WS_WOS = 56 * MiB, WS_WOUT = 64 * MiB;
constexpr size_t WS_WGU = 72 * MiB;
constexpr size_t WS_WD = 424 * MiB;
constexpr size_t WS_AFF = 600 * MiB;
constexpr size_t WS_AFFT = 603 * MiB;
constexpr size_t WS_INV = 606 * MiB;
constexpr size_t WS_SELI = 609 * MiB;
constexpr size_t WS_SELW = 609 * MiB + 512 * 1024;
constexpr size_t WS_U_FWD = 612 * MiB;
constexpr size_t WS_SGW = 610 * MiB;
constexpr size_t WS_SGU = 610 * MiB + 512 * 1024;
constexpr size_t WS_HS = 611 * MiB;
constexpr size_t WS_XS = 611 * MiB + 256 * 1024;
constexpr size_t WS_WDT = WS_U_FWD + 352 * MiB;
constexpr size_t WS_EMAX = 64 * 1024;
constexpr size_t WS_WSC = 611 * MiB + 640 * 1024;
constexpr size_t WS_H1Q = WS_WGU + 176 * MiB;
constexpr size_t WS_WIN8 = WS_WGU + 272 * MiB;
constexpr size_t WS_ATT8 = WS_H1Q;
constexpr size_t WS_WOA8 = WS_WIN8 + 24 * MiB;
constexpr size_t WS_OMAX = 64 * 1024 + 256;
constexpr size_t WS_WSCO = 610 * MiB + 960 * 1024;
constexpr size_t WS_MQ = WS_H1Q;
constexpr size_t WS_MS = WS_XS;
constexpr size_t WS_SWO = 610 * MiB + 976 * 1024;
constexpr size_t WS_HS1 = WS_XS;
constexpr size_t WS_SWIN = 610 * MiB + 896 * 1024;
constexpr size_t WS_CMAXIN = 512 * 1024 + 64 * 1024;
constexpr size_t WS_CMAX = 128 * 1024;
constexpr int NGUROWS = NE * 22 * 256;
constexpr size_t WS_U = 612 * MiB, WS_VG = 804 * MiB, WS_Q = 996 * MiB, WS_GA = 1188 * MiB, WS_GS = 1380 * MiB, WS_END = 1572 * MiB;
constexpr size_t WS_XE = WS_Q;
constexpr size_t WS_GUT = WS_U;
constexpr size_t WS_ACT = WS_U;
constexpr size_t DO_H1 = 0, DO_K = 192 * MiB, DO_V = 240 * MiB, DO_VST = 288 * MiB;
constexpr int CW_TMO = 0, CW_BAR = 4096;

constexpr int RING_OFF = 0, RING_BYTES = 131072, AUX_OFF = 131072, AUX_BYTES = 16384, MISC_OFF = AUX_OFF + AUX_BYTES, LDS_BYTES = MISC_OFF + 256;

#define GAS __attribute__((address_space(1)))
#define LAS __attribute__((address_space(3)))
typedef unsigned short bf16;
typedef unsigned v4u __attribute__((ext_vector_type(4)));
typedef unsigned v2u __attribute__((ext_vector_type(2)));
typedef float f32x4 __attribute__((ext_vector_type(4)));
typedef GAS unsigned gu32;
#define RLX_AGENT __ATOMIC_RELAXED, __HIP_MEMORY_SCOPE_AGENT
#define LDS_WAIT() asm volatile("s_waitcnt lgkmcnt(0)" ::: "memory")
#define VM_WAIT() asm volatile("s_waitcnt vmcnt(0)" ::: "memory")
using pg8::cvt_pk_bf16; using pg8::bf_lo; using pg8::bf_hi;

#define XB_TMO      128
#define XB_XCNT(j)  (256  + 64 * (j))
#define XB_XSUB(j)  (1280 + 64 * (j))
#define XB_XGEN(j)  (2304 + 64 * (j))
#define XB_TOP      3328
#define XB_TOPGEN   3392
#define XCD_BAR_WORDS 3456
#define XB_SPIN_CAP (1u << 22)
__device__ __forceinline__ unsigned xb_ld(unsigned* p)              { return __hip_atomic_load(p, __ATOMIC_RELAXED, __HIP_MEMORY_SCOPE_AGENT); }
__device__ __forceinline__ unsigned xb_add(unsigned* p, unsigned v) { return __hip_atomic_fetch_add(p, v, __ATOMIC_RELAXED, __HIP_MEMORY_SCOPE_AGENT); }
__device__ __forceinline__ unsigned xb_xcc_id() { return (unsigned)__builtin_amdgcn_s_getreg((3 << 11) | 20) & 0xFu; }
#define XB_SPIN(cond, bar) do { unsigned _sp = 0; while (cond) { __builtin_amdgcn_s_sleep(1); \
    if ((++_sp & 255u) == 0u) { if (xb_ld(&(bar)[XB_TMO])) break; if (_sp > XB_SPIN_CAP) { atomicAdd(&(bar)[XB_TMO], 1u); break; } } } } while (0)
struct XcdBarrier { unsigned* bar; unsigned x; volatile LAS unsigned* st; int wave; };
__device__ __forceinline__ XcdBarrier xcd_barrier_post(unsigned* bar, volatile LAS unsigned* st) {
    XcdBarrier b; b.bar = bar; b.x = xb_xcc_id(); b.st = st; b.wave = __builtin_amdgcn_readfirstlane((int)threadIdx.x >> 6);
    if (threadIdx.x == 0) (void)xb_add(&bar[XB_XCNT(b.x)], 1u);
    return b;
}
__device__ __forceinline__ void xcd_barrier_complete(unsigned* bar, unsigned x, unsigned& nloc, unsigned& nx) {
    const unsigned G = gridDim.x * gridDim.y * gridDim.z;
    unsigned sum, cnt, mine, sp = 0u;
    for (;;) {
        sum = 0u; cnt = 0u; mine = 0u;
#pragma unroll
        for (unsigned j = 0; j < 16; ++j) { const unsigned c = xb_ld(&bar[XB_XCNT(j)]); sum += c; cnt += (c > 0u) ? 1u : 0u; mine = (j == x) ? c : mine; }
        if (sum == G) break;
        __builtin_amdgcn_s_sleep(1);
        if ((++sp & 255u) == 0u) { if (xb_ld(&bar[XB_TMO])) break; if (sp > XB_SPIN_CAP) { atomicAdd(&bar[XB_TMO], 1u); break; } }
    }
    nloc = mine > 0u ? mine : 1u; nx = cnt > 0u ? cnt : 1u;
}
__device__ __forceinline__ void xcd_barrier(const XcdBarrier& b) {
    asm volatile("s_waitcnt vmcnt(0)" ::: "memory");
    __syncthreads();
    int l0_; asm volatile("v_mbcnt_lo_u32_b32 %0, -1, 0\n\tv_mbcnt_hi_u32_b32 %0, -1, %0" : "=v"(l0_));
    if (b.wave == 0 && l0_ == 0) {
        unsigned* bar = b.bar;
        __builtin_amdgcn_s_waitcnt(0);
        unsigned nloc = b.st[0], nx = b.st[1];
        if (nloc == 0u) { xcd_barrier_complete(bar, b.x, nloc, nx); b.st[0] = nloc; b.st[1] = nx; }
        const unsigned old = xb_add(&bar[XB_XSUB(b.x)], 1u);
        const unsigned gen = old / nloc;
        if (old + 1u == (gen + 1u) * nloc) {
            __builtin_amdgcn_fence(__ATOMIC_RELEASE, "agent");
            asm volatile("s_waitcnt vmcnt(0)" ::: "memory");
            const unsigned og = xb_add(&bar[XB_TOP], 1u);
            const unsigned tg = og / nx;
            if (og + 1u == (tg + 1u) * nx) xb_add(&bar[XB_TOPGEN], 1u);
            else XB_SPIN(xb_ld(&bar[XB_TOPGEN]) == tg, bar);
            __builtin_amdgcn_fence(__ATOMIC_ACQUIRE, "agent");
            xb_add(&bar[XB_XGEN(b.x)], 1u);
            asm volatile("s_waitcnt vmcnt(0)" ::: "memory");
        } else {
            XB_SPIN(xb_ld(&bar[XB_XGEN(b.x)]) == gen, bar);
            __builtin_amdgcn_fence(__ATOMIC_ACQUIRE, "agent");
            asm volatile("s_waitcnt vmcnt(0)" ::: "memory");
        }
    }
    __syncthreads();
}

struct Args { const float* in[23]; float* out; unsigned char* ws; int ph_lo, ph_hi, li, pad; };
struct Frame {
    LAS unsigned char* lds;
    int tid, lane, wave, vcu, G;
    const float* const* in;
    float* out; unsigned char* ws;
};
__device__ __forceinline__ int fresh_lane() { int l; asm volatile("v_mbcnt_lo_u32_b32 %0, -1, 0\n\tv_mbcnt_hi_u32_b32 %0, -1, %0" : "=v"(l)); return l; }
template <int CTRL> __device__ __forceinline__ float dpp_mov(float v) { return __int_as_float(__builtin_amdgcn_update_dpp(0, __float_as_int(v), CTRL, 0xF, 0xF, true)); }
__device__ __forceinline__ float lane_bcast(float v, int l) { return __int_as_float(__builtin_amdgcn_readlane(__float_as_int(v), l)); }
__device__ __forceinline__ float wave_sum(float v) {
    v += dpp_mov<0xB1>(v); v += dpp_mov<0x4E>(v); v += dpp_mov<0x141>(v); v += dpp_mov<0x140>(v);
    return (lane_bcast(v, 0) + lane_bcast(v, 16)) + (lane_bcast(v, 32) + lane_bcast(v, 48));
}
__device__ __forceinline__ int wave_sum_i(int v) {
    v += __builtin_amdgcn_update_dpp(0, v, 0xB1, 0xF, 0xF, true); v += __builtin_amdgcn_update_dpp(0, v, 0x4E, 0xF, 0xF, true); v += __builtin_amdgcn_update_dpp(0, v, 0x141, 0xF, 0xF, true); v += __builtin_amdgcn_update_dpp(0, v, 0x140, 0xF, 0xF, true);
    return (__builtin_amdgcn_readlane(v, 0) + __builtin_amdgcn_readlane(v, 16)) + (__builtin_amdgcn_readlane(v, 32) + __builtin_amdgcn_readlane(v, 48));
}
__device__ __forceinline__ float wave_max(float v) {
    v = fmaxf(v, dpp_mov<0xB1>(v)); v = fmaxf(v, dpp_mov<0x4E>(v)); v = fmaxf(v, dpp_mov<0x141>(v)); v = fmaxf(v, dpp_mov<0x140>(v));
    return fmaxf(fmaxf(lane_bcast(v, 0), lane_bcast(v, 16)), fmaxf(lane_bcast(v, 32), lane_bcast(v, 48)));
}
__device__ __forceinline__ int seq_of(int m) { return m < TP ? (m >> 12) : 4 + ((m - TP) >> 14); }
__device__ __forceinline__ int seq_start(int s) { return s < 4 ? s * 4096 : TP + (s - 4) * 16384; }
__device__ __forceinline__ int seq_len(int s) { return s < 4 ? 4096 : 16384; }
__device__ __forceinline__ const float* xrow_ptr(const Frame& F, int m) { return m < TP ? F.in[0] + (size_t)m * D : F.in[1] + (size_t)(m - TP) * D; }

__device__ __forceinline__ void ada_item(const Frame& F, int it, LAS float* scr) {
    const int kc = it / 48, jc = it % 48, lane = F.lane;
#pragma unroll
    for (int s = 0; s < NSEQ; ++s) { const float* cp = s < 4 ? F.in[2] + s * D : F.in[3] + (s - 4) * D;
#pragma unroll
        for (int i = 0; i < 4; ++i) { const float v = cp[kc * 256 + lane + 64 * i]; scr[s * 256 + lane + 64 * i] = v / (1.0f + __expf(-v)); } }
    LDS_WAIT(); asm volatile("" ::: "memory");
    f32x4 acc[NSEQ];
#pragma unroll
    for (int s = 0; s < NSEQ; ++s) acc[s] = (f32x4){0.f, 0.f, 0.f, 0.f};
    const float* wp = F.in[4] + (size_t)(kc * 256) * MODW + jc * 256 + 4 * lane;
#pragma unroll 8
    for (int k = 0; k < 256; ++k) { const f32x4 w = *(const f32x4*)(wp + (size_t)k * MODW);
#pragma unroll
        for (int s = 0; s < NSEQ; ++s) acc[s] += w * scr[s * 256 + k]; }
    float* modp = (float*)(F.ws + WS_MODP);
#pragma unroll
    for (int s = 0; s < NSEQ; ++s) *(f32x4*)(modp + (size_t)(kc * NSEQ + s) * MODW + jc * 256 + 4 * lane) = acc[s];
    LDS_WAIT(); asm volatile("" ::: "memory");
}
__device__ __forceinline__ int q8(float v) { return (int)rintf(fminf(fmaxf(v, -127.0f), 127.0f)); }
__device__ __forceinline__ unsigned q8x4(float a, float b, float c, float d, float inv) {
    typedef float f2_t __attribute__((ext_vector_type(2))); const f2_t mm = {inv, inv}, mg = {12582912.0f, 12582912.0f};
    const f2_t y0 = __builtin_elementwise_fma((f2_t){a, b}, mm, mg), y1 = __builtin_elementwise_fma((f2_t){c, d}, mm, mg);
    return __builtin_amdgcn_perm(__builtin_amdgcn_perm(__float_as_uint(y1.y), __float_as_uint(y1.x), 0x0c0c0400u), __builtin_amdgcn_perm(__float_as_uint(y0.y), __float_as_uint(y0.x), 0x0c0c0400u), 0x05040100u);
}
template <int NC, int FMT  , int K> __device__ __forceinline__ void strip_item(const Frame& F, const float* W, int ldw, unsigned char* dst, size_t dst_pitch, float* scale_out) {
    constexpr int CGS = NC / 4, RPW = 64 / CGS;
    const int lane = F.lane, w = F.wave, cg = lane % CGS, rp = lane / CGS;
    LAS unsigned* strip = (LAS unsigned*)(F.lds + RING_OFF); LAS float* cmx = (LAS float*)(F.lds + AUX_OFF + 2048);
    constexpr int PITCH = K / 2; const int swA = (NC == 32 ? 4 : 8) * cg;
    float mx[4] = {0.f, 0.f, 0.f, 0.f};
    constexpr int rows_per_step = NWAVES * 2 * RPW, nsteps = K / rows_per_step;
    const float* wp = W + (size_t)(w * 2 * RPW + 2 * rp) * ldw + 4 * cg;
    f32x4 ra0[4], rb0[4], ra1[4], rb1[4];
#define ST_LOAD(ra, rb, s0) do { _Pragma("unroll") for (int u = 0; u < 4; ++u) if ((s0) + u < nsteps) { const float* q = wp + (size_t)((s0) + u) * rows_per_step * ldw; ra[u] = *(const f32x4*)q; rb[u] = *(const f32x4*)(q + ldw); } } while (0)
#define ST_PROC(ra, rb, s0) do { _Pragma("unroll") for (int u = 0; u < 4; ++u) if ((s0) + u < nsteps) { const int kp = (((s0) + u) * rows_per_step) / 2 + w * RPW + rp; \
        _Pragma("unroll") for (int c = 0; c < 4; ++c) { mx[c] = fmaxf(mx[c], fmaxf(fabsf(ra[u][c]), fabsf(rb[u][c]))); strip[(4 * cg + c) * PITCH + (kp ^ swA)] = cvt_pk_bf16(ra[u][c], rb[u][c]); } } } while (0)
    ST_LOAD(ra0, rb0, 0);
#pragma unroll
    for (int st = 0; st < nsteps; st += 8) {
        if (st + 4 < nsteps) ST_LOAD(ra1, rb1, st + 4);
        ST_PROC(ra0, rb0, st);
        if (st + 8 < nsteps) ST_LOAD(ra0, rb0, st + 8);
        if (st + 4 < nsteps) ST_PROC(ra1, rb1, st + 4);
    }
#undef ST_LOAD
#undef ST_PROC
#pragma unroll
    for (int c = 0; c < 4; ++c) { float m = mx[c];
#pragma unroll
        for (int o = CGS; o < 64; o <<= 1) m = fmaxf(m, __shfl_xor(m, o));
        if (rp == 0) cmx[w * NC + 4 * cg + c] = m; }
    __syncthreads();
    constexpr int CPW = NC / NWAVES;
    constexpr int nchunk = K / 8;
#pragma unroll
    for (int ci = 0; ci < CPW; ++ci) { const int n = w * CPW + ci; float amax = 0.f;
#pragma unroll
        for (int ww = 0; ww < NWAVES; ++ww) amax = fmaxf(amax, cmx[ww * NC + n]);
        const int swq = (NC == 32 ? 1 : 2) * ((n >> 2) % CGS);
        float mul, deq;
        if (FMT == 1) { mul = amax > 0.f ? 127.0f / amax : 0.f; deq = amax * (1.0f / 127.0f); }
        else if (FMT == 2) { const int sft = amax > 0.f ? (int)floorf(log2f(448.0f / amax)) : 0; mul = exp2f((float)sft); deq = exp2f(-(float)sft); }
        else { mul = 1.f; deq = 1.f; }
        const LAS unsigned char* rowp = (const LAS unsigned char*)(strip + n * PITCH); unsigned char* drow = dst + (size_t)n * dst_pitch;
        for (int pc = lane; pc < nchunk; pc += 64) { const v4u x = *(const LAS v4u*)(rowp + pc * 16); const int q = pc ^ swq;
            if (FMT == 0) *(v4u*)(drow + q * 16) = x;
            else if (FMT == 1) { v2u o; o.x = q8x4(bf_lo(x.x), bf_hi(x.x), bf_lo(x.y), bf_hi(x.y), mul); o.y = q8x4(bf_lo(x.z), bf_hi(x.z), bf_lo(x.w), bf_hi(x.w), mul); *(v2u*)(drow + q * 8) = o; }
            else { v2u o; unsigned t = 0u; t = __builtin_amdgcn_cvt_pk_fp8_f32(bf_lo(x.x) * mul, bf_hi(x.x) * mul, t, false); t = __builtin_amdgcn_cvt_pk_fp8_f32(bf_lo(x.y) * mul, bf_hi(x.y) * mul, t, true); o.x = t;
                t = __builtin_amdgcn_cvt_pk_fp8_f32(bf_lo(x.z) * mul, bf_hi(x.z) * mul, t, false); t = __builtin_amdgcn_cvt_pk_fp8_f32(bf_lo(x.w) * mul, bf_hi(x.w) * mul, t, true); o.y = t; *(v2u*)(drow + q * 8) = o; } }
        if (FMT != 0 && lane == 0) scale_out[n] = deq; }
    __syncthreads();
}
__device__ __forceinline__ void p0_prologue(const Frame& F) {
    { LAS float* scr = (LAS float*)(F.lds + RING_OFF + F.wave * 16384);
      const int gw = F.vcu * NWAVES + F.wave, NGW = F.G * NWAVES; constexpr int I_ADA = ADA_KC * 48, I_SGW = 64;
      for (int it = gw; it < I_ADA + I_SGW; it += NGW) {
          if (it < I_ADA) { ada_item(F, it, scr); continue; }
          const int r = it - I_ADA; const float* src = F.in[14] + (size_t)r * 4096; bf16* dst = (bf16*)(F.ws + WS_SGW) + (size_t)r * 4096;
#pragma unroll
          for (int q = 0; q < 8; ++q) { const f32x4 a = *(const f32x4*)(src + 8 * (F.lane + 64 * q)), b = *(const f32x4*)(src + 8 * (F.lane + 64 * q) + 4);
              v4u o; o.x = cvt_pk_bf16(a.x, a.y); o.y = cvt_pk_bf16(a.z, a.w); o.z = cvt_pk_bf16(b.x, b.y); o.w = cvt_pk_bf16(b.z, b.w); *(v4u*)(dst + 8 * (F.lane + 64 * q)) = o; } } }
    __syncthreads();
    constexpr int S_IN = IN_W / 32, S_O = D / 32, S_GU = NE * 2 * (FF / 32), S_DN = NE * (D / 16), NSTRIP = S_IN + 3 * S_O + S_GU + S_DN;
    unsigned char* const ws = F.ws;
    for (int it = F.vcu; it < NSTRIP; it += F.G) {
        int r = it;
        if (r < S_GU) { const int mat = r / (FF / 32), nb = r % (FF / 32), e = mat >> 1, up = mat & 1, n0 = 32 * nb;
            const size_t drow = (size_t)(e * 22 + n0 / 128) * 256 + up * 128 + (n0 % 128);
            strip_item<32, 1, D>(F, F.in[up ? 21 : 20] + (size_t)e * D * FF + n0, FF, ws + WS_WGU + drow * D, D, (float*)(ws + WS_SGU) + drow); continue; } r -= S_GU;
        if (r < S_DN) { const int e = r / (D / 16), n0 = 16 * (r % (D / 16));
            strip_item<16, 2, FF>(F, F.in[22] + (size_t)e * FF * D + n0, D, ws + WS_WD + ((size_t)e * D + n0) * FF, FF, (float*)(ws + WS_WSC) + e * D + n0); continue; } r -= S_DN;
        if (r < S_IN) { const int n0 = 32 * r; strip_item<32, 1, D>(F, F.in[8] + n0, IN_W, ws + WS_WIN8 + (size_t)n0 * D, D, (float*)(ws + WS_SWIN) + n0); continue; } r -= S_IN;
        { const int wsel = r / S_O, n0 = 32 * (r % S_O);
          if (wsel == 0) strip_item<32, 2, D>(F, F.in[16] + n0, D, ws + WS_WOA8 + (size_t)n0 * D, D, (float*)(ws + WS_WSCO) + n0);
          else if (wsel == 1) strip_item<32, 0, D>(F, F.in[17] + n0, D, ws + WS_WOS + (size_t)n0 * D * 2, D * 2, nullptr);
          else strip_item<32, 1, D>(F, F.in[18] + n0, D, ws + WS_WOUT + (size_t)n0 * D, D, (float*)(ws + WS_SWO) + n0); }
    }
}

template <int WHICH> __device__ __forceinline__ void load_modl(const Frame& F, int s, LAS float* modl) {
    const float* modp = (const float*)(F.ws + WS_MODP); const float* mod = (const float*)(F.ws + WS_MOD); const float* bada = F.in[5];
    for (int j = F.tid; j < 2 * D; j += NWAVES * 64) {
        float v;
        if (WHICH == 1) { const int col = j; v = bada[col];
#pragma unroll
            for (int kc = 0; kc < ADA_KC; ++kc) v += modp[(size_t)(kc * NSEQ + s) * MODW + col]; }
        else v = mod[(size_t)s * MODW + 3 * D + j];
        modl[j] = (j >= D) ? (1.0f + v) * F.in[WHICH == 1 ? 6 : 7][j - D] : v;
    }
}
__device__ __forceinline__ void p1_rows(const Frame& F) {
    LAS float* modl = (LAS float*)(F.lds + AUX_OFF);
    { const float* modp = (const float*)(F.ws + WS_MODP); float* mod = (float*)(F.ws + WS_MOD); const float* bada = F.in[5];
      for (int idx = F.vcu * 512 + F.tid; idx < NSEQ * MODW; idx += F.G * 512) { const int s = idx / MODW, j = idx % MODW; float v = bada[j];
#pragma unroll
          for (int kc = 0; kc < ADA_KC; ++kc) v += modp[(size_t)(kc * NSEQ + s) * MODW + j];
          mod[idx] = v; } }
    const int RPB = (M + F.G - 1) / F.G, r0 = F.vcu * RPB, r1 = (r0 + RPB < M) ? r0 + RPB : M;
    unsigned* h1q = (unsigned*)(F.ws + WS_H1Q); float* hs1 = (float*)(F.ws + WS_HS1);
    const float* g1n = F.in[6]; bf16* h1 = (DBG_NPH == 3) ? (bf16*)(F.ws + WS_WGU) : (bf16*)((unsigned char*)F.out + DO_H1);
    for (int row = r0; row < r1;) {
        const int s = seq_of(row); int end = seq_start(s) + seq_len(s); if (end > r1) end = r1;
        load_modl<1>(F, s, modl);
        __syncthreads();
        f32x4 vn[8];
        { const int mf = row + F.wave; if (mf < end) { const f32x4* xr = (const f32x4*)xrow_ptr(F, mf) + F.lane;
#pragma unroll
            for (int j = 0; j < 8; ++j) vn[j] = xr[64 * j]; } }
        for (int m = row + F.wave; m < end; m += NWAVES) {
            f32x4 v[8]; float ss = 0.f;
#pragma unroll
            for (int j = 0; j < 8; ++j) v[j] = vn[j];
            if (m + NWAVES < end) { const f32x4* xr = (const f32x4*)xrow_ptr(F, m + NWAVES) + F.lane;
#pragma unroll
                for (int j = 0; j < 8; ++j) vn[j] = xr[64 * j]; }
#pragma unroll
            for (int j = 0; j < 8; ++j) ss += (v[j].x * v[j].x + v[j].y * v[j].y) + (v[j].z * v[j].z + v[j].w * v[j].w);
            const float rstd = 1.0f / sqrtf(wave_sum(ss) * (1.0f / D) + NORM_EPS);
            float amax = 0.f;
#pragma unroll
            for (int j = 0; j < 8; ++j) { const int d = 4 * (F.lane + 64 * j);
                const f32x4 sh = *(const LAS f32x4*)(modl + d), sc = *(const LAS f32x4*)(modl + D + d);
                const f32x4 y = v[j] * rstd * sc + sh; v[j] = y; amax = fmaxf(fmaxf(amax, fmaxf(fabsf(y.x), fabsf(y.y))), fmaxf(fabsf(y.z), fabsf(y.w)));
                }
            amax = wave_max(amax);
            { const float inv = amax > 0.f ? 127.0f / amax : 0.f; unsigned* o4 = h1q + (size_t)m * (D / 4) + F.lane;
#pragma unroll
              for (int j = 0; j < 8; ++j) o4[64 * j] = q8x4(v[j].x, v[j].y, v[j].z, v[j].w, inv);
              if (F.lane == 0) hs1[m] = amax * (1.0f / 127.0f); }
        }
        __syncthreads();
        row = end;
    }
}
__device__ __forceinline__ void p6_rows(const Frame& F) {
    LAS float* modl = (LAS float*)(F.lds + AUX_OFF);
    LAS float* wrt = (LAS float*)(F.lds + RING_OFF);
    { const float* wr = F.in[19]; for (int idx = F.tid; idx < D * NE; idx += NWAVES * 64) wrt[(idx & 15) * D + (idx >> 4)] = wr[idx]; }
    const int RPB = (M + F.G - 1) / F.G, r0 = F.vcu * RPB, r1 = (r0 + RPB < M) ? r0 + RPB : M;
    const float* g2n = F.in[7]; unsigned* h2q = (unsigned*)(F.ws + WS_Q); float* hs = (float*)(F.ws + WS_HS);
    float* aff = (float*)(F.ws + WS_AFF); float* affT = (float*)(F.ws + WS_AFFT);
    for (int row = r0; row < r1;) {
        const int s = seq_of(row); int end = seq_start(s) + seq_len(s); if (end > r1) end = r1;
        load_modl<2>(F, s, modl);
        __syncthreads();
        f32x4 vn0[8], vn1[8];
        { const int mf = row + 2 * F.wave; if (mf < end) { const int mf1 = mf + 1 < end ? mf + 1 : mf; const f32x4* x0 = (const f32x4*)(F.out + (size_t)mf * D) + F.lane; const f32x4* x1 = (const f32x4*)(F.out + (size_t)mf1 * D) + F.lane;
#pragma unroll
            for (int j = 0; j < 8; ++j) { vn0[j] = x0[64 * j]; vn1[j] = x1[64 * j]; } } }
        for (int m = row + 2 * F.wave; m < end; m += 2 * NWAVES) {
            const bool two = m + 1 < end; const int m1 = two ? m + 1 : m;
            f32x4 v0[8], v1[8]; float ss0 = 0.f, ss1 = 0.f;
#pragma unroll
            for (int j = 0; j < 8; ++j) { v0[j] = vn0[j]; v1[j] = vn1[j]; }
            if (m + 2 * NWAVES < end) { const int mn = m + 2 * NWAVES, mn1 = mn + 1 < end ? mn + 1 : mn; const f32x4* x0 = (const f32x4*)(F.out + (size_t)mn * D) + F.lane; const f32x4* x1 = (const f32x4*)(F.out + (size_t)mn1 * D) + F.lane;
#pragma unroll
                for (int j = 0; j < 8; ++j) { vn0[j] = x0[64 * j]; vn1[j] = x1[64 * j]; } }
#pragma unroll
            for (int j = 0; j < 8; ++j) { ss0 += (v0[j].x * v0[j].x + v0[j].y * v0[j].y) + (v0[j].z * v0[j].z + v0[j].w * v0[j].w); ss1 += (v1[j].x * v1[j].x + v1[j].y * v1[j].y) + (v1[j].z * v1[j].z + v1[j].w * v1[j].w); }
            const float rstd0 = 1.0f / sqrtf(wave_sum(ss0) * (1.0f / D) + NORM_EPS), rstd1 = 1.0f / sqrtf(wave_sum(ss1) * (1.0f / D) + NORM_EPS);
            float amax0 = 0.f, amax1 = 0.f;
#pragma unroll
            for (int j = 0; j < 8; ++j) { const int d = 4 * (F.lane + 64 * j);
                const f32x4 sh = *(const LAS f32x4*)(modl + d), gs = *(const LAS f32x4*)(modl + D + d);
                const f32x4 y0 = v0[j] * rstd0 * gs + sh, y1 = v1[j] * rstd1 * gs + sh; v0[j] = y0; v1[j] = y1;
                amax0 = fmaxf(fmaxf(amax0, fmaxf(fabsf(y0.x), fabsf(y0.y))), fmaxf(fabsf(y0.z), fabsf(y0.w))); amax1 = fmaxf(fmaxf(amax1, fmaxf(fabsf(y1.x), fabsf(y1.y))), fmaxf(fabsf(y1.z), fabsf(y1.w))); }
            amax0 = wave_max(amax0); amax1 = wave_max(amax1);
            { const float inv = amax0 > 0.f ? 127.0f / amax0 : 0.f; unsigned* o4 = h2q + (size_t)m * (D / 4) + F.lane;
#pragma unroll
              for (int j = 0; j < 8; ++j) o4[64 * j] = q8x4(v0[j].x, v0[j].y, v0[j].z, v0[j].w, inv);
              if (F.lane == 0) hs[m] = amax0 * (1.0f / 127.0f); }
            if (two) { const float inv = amax1 > 0.f ? 127.0f / amax1 : 0.f; unsigned* o4 = h2q + (size_t)m1 * (D / 4) + F.lane;
#pragma unroll
              for (int j = 0; j < 8; ++j) o4[64 * j] = q8x4(v1[j].x, v1[j].y, v1[j].z, v1[j].w, inv);
              if (F.lane == 0) hs[m1] = amax1 * (1.0f / 127.0f); }
            asm volatile("" ::: "memory");
            float lg0[NE], lg1[NE];
#pragma unroll
            for (int e = 0; e < NE; ++e) { f32x4 a0 = {0.f, 0.f, 0.f, 0.f}, a1 = {0.f, 0.f, 0.f, 0.f};
#pragma unroll
                for (int j = 0; j < 8; ++j) { const f32x4 wv = *(const LAS f32x4*)(wrt + e * D + 4 * (F.lane + 64 * j)); a0 += v0[j] * wv; a1 += v1[j] * wv; }
                lg0[e] = (a0.x + a0.y) + (a0.z + a0.w); lg1[e] = (a1.x + a1.y) + (a1.z + a1.w); asm volatile("" ::: "memory"); }
            const int ln = F.lane;
#define P6_TREDUCE(lg, lgt) do { float r8[8], r4[4], r2[2]; \
            { const bool hb = (ln >> 5) & 1; _Pragma("unroll") for (int i = 0; i < 8; ++i) { const float keep = hb ? lg[8 + i] : lg[i], send = hb ? lg[i] : lg[8 + i]; r8[i] = keep + __shfl_xor(send, 32); } } \
            { const bool hb = (ln >> 4) & 1; _Pragma("unroll") for (int i = 0; i < 4; ++i) { const float keep = hb ? r8[4 + i] : r8[i], send = hb ? r8[i] : r8[4 + i]; r4[i] = keep + __shfl_xor(send, 16); } } \
            { const bool hb = (ln >> 3) & 1; _Pragma("unroll") for (int i = 0; i < 2; ++i) { const float keep = hb ? r4[2 + i] : r4[i], send = hb ? r4[i] : r4[2 + i]; r2[i] = keep + __shfl_xor(send, 8); } } \
            { const bool hb = (ln >> 2) & 1; const float keep = hb ? r2[1] : r2[0], send = hb ? r2[0] : r2[1]; lgt = keep + __shfl_xor(send, 4); } \
            lgt += __shfl_xor(lgt, 1); lgt += __shfl_xor(lgt, 2); } while (0)
#define P6_SOFTMAX_STORE(lgt, mrow) do { float mx = lgt; _Pragma("unroll") for (int o = 4; o < 64; o <<= 1) mx = fmaxf(mx, __shfl_xor(mx, o)); \
            const float ex = expf(lgt - mx); float den = ex; _Pragma("unroll") for (int o = 4; o < 64; o <<= 1) den += __shfl_xor(den, o); \
            const float mine = ex / den; const int e = ln >> 2; \
            if ((ln & 3) == 0) { aff[(size_t)(mrow) * NE + e] = mine; \
                if ((mrow) < TP) affT[(size_t)e * TP + (mrow)] = mine; else affT[(size_t)NE * TP + (size_t)e * TS + ((mrow) - TP)] = mine; } } while (0)
            float lgt0, lgt1; P6_TREDUCE(lg0, lgt0); P6_TREDUCE(lg1, lgt1);
            P6_SOFTMAX_STORE(lgt0, m);
            if (two) P6_SOFTMAX_STORE(lgt1, m1);
#undef P6_TREDUCE
#undef P6_SOFTMAX_STORE
        }
        __syncthreads();
        row = end;
    }
}

using pg8::Unit; using pg8::bf16_t;
__device__ __forceinline__ float gelu_tanh(float x) { const float t = x * (1.0f + 0.044715f * x * x) * (-2.0f * 0.7978845608028654f * 1.4426950408889634f); return x * __builtin_amdgcn_rcpf(1.0f + __builtin_amdgcn_exp2f(t)); }
__device__ __forceinline__ float sigmoid_f(float x) { return __builtin_amdgcn_rcpf(1.0f + __builtin_amdgcn_exp2f(-1.4426950408889634f * x)); }
template <int ACT> __device__ __forceinline__ float act_f(float x) { return ACT == 1 ? gelu_tanh(x) : (ACT == 2 || ACT == 3) ? sigmoid_f(x) : x; }
template <int ACT> __device__ __forceinline__ void store_tile_bf16(const f32x4 (&acc)[2][2][4][2], bf16_t* base, int ldc, int row0, int col0) {
#pragma unroll
    for (int ai = 0; ai < 2; ++ai)
#pragma unroll
        for (int m = 0; m < 4; ++m) { bf16_t* rowp = base + (size_t)(row0 + ai * 128 + m * 16) * ldc + col0;
#pragma unroll
            for (int bj = 0; bj < 2; ++bj) { const f32x4 v0 = acc[ai][bj][m][0], v1 = acc[ai][bj][m][1]; v4u w;
                w.x = cvt_pk_bf16(act_f<ACT>(v0[0]), act_f<ACT>(v0[1])); w.y = cvt_pk_bf16(act_f<ACT>(v0[2]), act_f<ACT>(v0[3]));
                w.z = cvt_pk_bf16(act_f<ACT>(v1[0]), act_f<ACT>(v1[1])); w.w = cvt_pk_bf16(act_f<ACT>(v1[2]), act_f<ACT>(v1[3]));
                *(v4u*)(rowp + bj * 128) = w; } }
}
struct EpiIn {
    bf16_t *Q, *Kb, *Vb, *U, *VG, *GA, *GS; float* VST;
    __device__ __forceinline__ void operator()(const f32x4 (&acc)[2][2][4][2], const Unit& u, int wr, int wc, int fr, int fq) const {
        const int pn = u.pn; bf16_t* base; int ldc, colt, act;
        if (pn < 8) { base = Q; ldc = D; colt = pn * 256; act = 0; }
        else if (pn < 10) { base = Kb; ldc = KVW; colt = (pn - 8) * 256; act = 0; }
        else if (pn < 12) { base = Vb; ldc = KVW; colt = (pn - 10) * 256; act = 0; }
        else if (pn < 20) { base = U; ldc = D; colt = (pn - 12) * 256; act = 1; }
        else if (pn < 28) { base = VG; ldc = D; colt = (pn - 20) * 256; act = 1; }
        else if (pn < 36) { base = GA; ldc = D; colt = (pn - 28) * 256; act = 2; }
        else { base = GS; ldc = D; colt = (pn - 36) * 256; act = 2; }
        const int row0 = u.pm * 256 + wr * 64 + fr, col0 = colt + wc * 32 + 8 * fq;
        if (act == 0) store_tile_bf16<0>(acc, base, ldc, row0, col0);
        else if (act == 2) store_tile_bf16<2>(acc, base, ldc, row0, col0);
        else if (pn < 20) store_tile_bf16<1>(acc, base, ldc, row0, col0);
        else {
            const int fq_ = fq;
#pragma unroll
            for (int ai = 0; ai < 2; ++ai)
#pragma unroll
                for (int m = 0; m < 4; ++m) { const int row = row0 + ai * 128 + m * 16; bf16_t* rowp = base + (size_t)row * ldc + col0; float s1 = 0.f, s2 = 0.f;
#pragma unroll
                    for (int bj = 0; bj < 2; ++bj) { const f32x4 v0 = acc[ai][bj][m][0], v1 = acc[ai][bj][m][1];
                        const float a0 = gelu_tanh(v0[0]), a1 = gelu_tanh(v0[1]), a2 = gelu_tanh(v0[2]), a3 = gelu_tanh(v0[3]), a4 = gelu_tanh(v1[0]), a5 = gelu_tanh(v1[1]), a6 = gelu_tanh(v1[2]), a7 = gelu_tanh(v1[3]);
                        s1 += ((a0 + a1) + (a2 + a3)) + ((a4 + a5) + (a6 + a7)); s2 += ((a0 * a0 + a1 * a1) + (a2 * a2 + a3 * a3)) + ((a4 * a4 + a5 * a5) + (a6 * a6 + a7 * a7));
                        v4u w; w.x = cvt_pk_bf16(a0, a1); w.y = cvt_pk_bf16(a2, a3); w.z = cvt_pk_bf16(a4, a5); w.w = cvt_pk_bf16(a6, a7); *(v4u*)(rowp + bj * 128) = w; }
                    s1 += __shfl_xor(s1, 16); s1 += __shfl_xor(s1, 32); s2 += __shfl_xor(s2, 16); s2 += __shfl_xor(s2, 32);
                    if (fq_ == 0) { float2 st2; st2.x = s1; st2.y = s2; *(float2*)(VST + ((size_t)row * 32 + (pn - 20) * 4 + wc) * 2) = st2; } }
        }
    }
};
template <int ACT> __device__ __forceinline__ void store_tile_i8(const pg8::i32x4 (&acc)[2][2][4][2], bf16_t* base, int ldc, int row0, int col0, const float* hs1, const float* sp) {
    f32x4 sc[2][2];
#pragma unroll
    for (int bj = 0; bj < 2; ++bj) { sc[bj][0] = *(const f32x4*)(sp + bj * 128); sc[bj][1] = *(const f32x4*)(sp + bj * 128 + 4); }
#pragma unroll
    for (int ai = 0; ai < 2; ++ai)
#pragma unroll
        for (int m = 0; m < 4; ++m) { const int row = row0 + ai * 128 + m * 16; const float xr = hs1[row]; bf16_t* rowp = base + (size_t)row * ldc + col0;
#pragma unroll
            for (int bj = 0; bj < 2; ++bj) { const pg8::i32x4 i0 = acc[ai][bj][m][0], i1 = acc[ai][bj][m][1];
                const f32x4 z0 = (f32x4){(float)i0[0], (float)i0[1], (float)i0[2], (float)i0[3]} * sc[bj][0] * xr, z1 = (f32x4){(float)i1[0], (float)i1[1], (float)i1[2], (float)i1[3]} * sc[bj][1] * xr; v4u w;
                if constexpr (ACT == 3) {
                    unsigned lo = 0u, hi = 0u;
                    lo = __builtin_amdgcn_cvt_pk_u8_f32(rintf(255.0f * sigmoid_f(z0[0])), 0, lo); lo = __builtin_amdgcn_cvt_pk_u8_f32(rintf(255.0f * sigmoid_f(z0[1])), 1, lo); lo = __builtin_amdgcn_cvt_pk_u8_f32(rintf(255.0f * sigmoid_f(z0[2])), 2, lo); lo = __builtin_amdgcn_cvt_pk_u8_f32(rintf(255.0f * sigmoid_f(z0[3])), 3, lo);
                    hi = __builtin_amdgcn_cvt_pk_u8_f32(rintf(255.0f * sigmoid_f(z1[0])), 0, hi); hi = __builtin_amdgcn_cvt_pk_u8_f32(rintf(255.0f * sigmoid_f(z1[1])), 1, hi); hi = __builtin_amdgcn_cvt_pk_u8_f32(rintf(255.0f * sigmoid_f(z1[2])), 2, hi); hi = __builtin_amdgcn_cvt_pk_u8_f32(rintf(255.0f * sigmoid_f(z1[3])), 3, hi);
                    *(v2u*)((unsigned char*)base + (size_t)row * ldc + col0 + bj * 128) = (v2u){lo, hi}; continue; }
                w.x = cvt_pk_bf16(act_f<ACT>(z0[0]), act_f<ACT>(z0[1])); w.y = cvt_pk_bf16(act_f<ACT>(z0[2]), act_f<ACT>(z0[3])); w.z = cvt_pk_bf16(act_f<ACT>(z1[0]), act_f<ACT>(z1[1])); w.w = cvt_pk_bf16(act_f<ACT>(z1[2]), act_f<ACT>(z1[3]));
                *(v4u*)(rowp + bj * 128) = w; } }
}
struct EpiGate {
    bf16_t *Q, *Kb, *Vb, *U, *VG, *GA, *GS; float* VST; const float* hs1; const float* swin; const float* gq; const float* gk; LAS float* P;
    __device__ __forceinline__ void operator()(const pg8::i32x4 (&acc)[2][2][4][2], const Unit& u, int wr, int wc, int fr, int fq) const {
        asm volatile("" : "+v"(fr), "+v"(fq));
        const int pn = u.pn; bf16_t* base; int ldc, colt;
        if (pn < 8) { base = Q; ldc = D; colt = pn * 256; }
        else if (pn < 10) { base = Kb; ldc = KVW; colt = (pn - 8) * 256; }
        else if (pn < 12) { base = Vb; ldc = KVW; colt = (pn - 10) * 256; }
        else if (pn < 20) { base = U; ldc = D; colt = (pn - 12) * 256; }
        else if (pn < 28) { base = VG; ldc = D; colt = (pn - 20) * 256; }
        else if (pn < 36) { base = GA; ldc = D; colt = (pn - 28) * 256; }
        else { base = GS; ldc = D; colt = (pn - 36) * 256; }
        const int row0 = u.pm * 256 + wr * 64 + fr, col0 = colt + wc * 32 + 8 * fq; const float* sp = swin + pn * 256 + wc * 32 + 8 * fq;
        if (pn < 10) {
            f32x4 sc[2][2];
#pragma unroll
            for (int bj = 0; bj < 2; ++bj) { sc[bj][0] = *(const f32x4*)(sp + bj * 128); sc[bj][1] = *(const f32x4*)(sp + bj * 128 + 4); }
#pragma unroll
            for (int ai = 0; ai < 2; ++ai)
#pragma unroll
                for (int m = 0; m < 4; ++m) { const int rl = ai * 128 + wr * 64 + m * 16 + fr; const float xr = hs1[u.pm * 256 + rl];
#pragma unroll
                    for (int bj = 0; bj < 2; ++bj) { const pg8::i32x4 i0 = acc[ai][bj][m][0], i1 = acc[ai][bj][m][1];
                        const f32x4 z0 = (f32x4){(float)i0[0], (float)i0[1], (float)i0[2], (float)i0[3]} * sc[bj][0] * xr, z1 = (f32x4){(float)i1[0], (float)i1[1], (float)i1[2], (float)i1[3]} * sc[bj][1] * xr;
                        float ss = ((z0[0] * z0[0] + z0[1] * z0[1]) + (z0[2] * z0[2] + z0[3] * z0[3])) + ((z1[0] * z1[0] + z1[1] * z1[1]) + (z1[2] * z1[2] + z1[3] * z1[3]));
                        ss += __shfl_xor(ss, 16); ss += __shfl_xor(ss, 32);
                        if (fq == 0) P[(rl * 2 + bj) * 4 + wc] = ss; } }
            asm volatile("s_waitcnt lgkmcnt(0)" ::: "memory"); __builtin_amdgcn_s_barrier(); asm volatile("" ::: "memory");
            if (pn < 8) { const int d = wc * 32 + 8 * fq; const f32x4 g0 = *(const f32x4*)(gq + d) * *(const f32x4*)(gk + d) * (0.08838834764831845f * 1.4426950408889634f), g1 = *(const f32x4*)(gq + d + 4) * *(const f32x4*)(gk + d + 4) * (0.08838834764831845f * 1.4426950408889634f);
#pragma unroll
                for (int bj = 0; bj < 2; ++bj) { sc[bj][0] *= g0; sc[bj][1] *= g1; } }
#pragma unroll
            for (int ai = 0; ai < 2; ++ai)
#pragma unroll
                for (int m = 0; m < 4; ++m) { const int rl = ai * 128 + wr * 64 + m * 16 + fr; const int row = u.pm * 256 + rl; const float xr = hs1[row]; bf16_t* rowp = base + (size_t)row * ldc + col0;
#pragma unroll
                    for (int bj = 0; bj < 2; ++bj) { const pg8::i32x4 i0 = acc[ai][bj][m][0], i1 = acc[ai][bj][m][1]; const f32x4 pp = *(const LAS f32x4*)(P + (rl * 2 + bj) * 4);
                        const float rn = (1.0f / sqrtf(((pp.x + pp.y) + (pp.z + pp.w)) * (1.0f / 128.0f) + NORM_EPS)) * xr;
                        const f32x4 z0 = (f32x4){(float)i0[0], (float)i0[1], (float)i0[2], (float)i0[3]} * sc[bj][0] * rn, z1 = (f32x4){(float)i1[0], (float)i1[1], (float)i1[2], (float)i1[3]} * sc[bj][1] * rn; v4u w;
                        w.x = cvt_pk_bf16(z0[0], z0[1]); w.y = cvt_pk_bf16(z0[2], z0[3]); w.z = cvt_pk_bf16(z1[0], z1[1]); w.w = cvt_pk_bf16(z1[2], z1[3]);
                        *(v4u*)(rowp + bj * 128) = w; } }
        }
        else if (pn < 12) store_tile_i8<0>(acc, base, ldc, row0, col0, hs1, sp);
        else if (pn < 20) store_tile_i8<1>(acc, base, ldc, row0, col0, hs1, sp);
        else if (pn >= 28) store_tile_i8<3>(acc, base, ldc, row0, col0, hs1, sp);
        else {
            f32x4 sc[2][2];
#pragma unroll
            for (int bj = 0; bj < 2; ++bj) { sc[bj][0] = *(const f32x4*)(sp + bj * 128); sc[bj][1] = *(const f32x4*)(sp + bj * 128 + 4); }
#pragma unroll
            for (int ai = 0; ai < 2; ++ai)
#pragma unroll
                for (int m = 0; m < 4; ++m) { const unsigned row = (unsigned)(row0 + ai * 128 + m * 16); const float xr = *(const float*)((const char*)hs1 + (size_t)(row * 4u));
                    bf16_t* rowp = (bf16_t*)((char*)base + (size_t)((row * (unsigned)ldc + (unsigned)col0) * 2u)); float s1 = 0.f, s2 = 0.f;
#pragma unroll
                    for (int bj = 0; bj < 2; ++bj) { const pg8::i32x4 i0 = acc[ai][bj][m][0], i1 = acc[ai][bj][m][1];
                        const f32x4 z0 = (f32x4){(float)i0[0], (float)i0[1], (float)i0[2], (float)i0[3]} * sc[bj][0] * xr, z1 = (f32x4){(float)i1[0], (float)i1[1], (float)i1[2], (float)i1[3]} * sc[bj][1] * xr;
                        const float a0 = gelu_tanh(z0[0]), a1 = gelu_tanh(z0[1]), a2 = gelu_tanh(z0[2]), a3 = gelu_tanh(z0[3]), a4 = gelu_tanh(z1[0]), a5 = gelu_tanh(z1[1]), a6 = gelu_tanh(z1[2]), a7 = gelu_tanh(z1[3]);
                        s1 += ((a0 + a1) + (a2 + a3)) + ((a4 + a5) + (a6 + a7)); s2 += ((a0 * a0 + a1 * a1) + (a2 * a2 + a3 * a3)) + ((a4 * a4 + a5 * a5) + (a6 * a6 + a7 * a7));
                        v4u w; w.x = cvt_pk_bf16(a0, a1); w.y = cvt_pk_bf16(a2, a3); w.z = cvt_pk_bf16(a4, a5); w.w = cvt_pk_bf16(a6, a7); *(v4u*)(rowp + bj * 128) = w; }
                    s1 += __shfl_xor(s1, 16); s1 += __shfl_xor(s1, 32); s2 += __shfl_xor(s2, 16); s2 += __shfl_xor(s2, 32);
                    if (fq == 0) { float2 st2; st2.x = s1; st2.y = s2; *(float2*)((char*)VST + (size_t)((row * 32u + (unsigned)((pn - 20) * 4 + wc)) * 8u)) = st2; } }
        }
    }
};
struct EpiMerge {
    bf16_t* T; const unsigned char* G8; const float* wsco; int half;
    __device__ __forceinline__ void operator()(const f32x4 (&acc)[2][2][4][2], const Unit& u, int wr, int wc, int fr, int fq) const {
        const int row0 = u.pm * 256 + wr * 64 + fr, col0 = u.pn * 256 + wc * 32 + 8 * fq;
        f32x4 cs[2][2];
#pragma unroll
        for (int bj = 0; bj < 2; ++bj) { cs[bj][0] = (half == 0 ? *(const f32x4*)(wsco + col0 + bj * 128) : (f32x4){1.f, 1.f, 1.f, 1.f}) * (1.0f / 255.0f); cs[bj][1] = (half == 0 ? *(const f32x4*)(wsco + col0 + bj * 128 + 4) : (f32x4){1.f, 1.f, 1.f, 1.f}) * (1.0f / 255.0f); }
#pragma unroll
        for (int ai = 0; ai < 2; ++ai)
#pragma unroll
            for (int m = 0; m < 4; ++m) { const size_t off = (size_t)(row0 + ai * 128 + m * 16) * D + col0;
#pragma unroll
                for (int bj = 0; bj < 2; ++bj) { const f32x4 v0 = acc[ai][bj][m][0] * cs[bj][0], v1 = acc[ai][bj][m][1] * cs[bj][1];
                    const v2u g = *(const v2u*)(G8 + off + bj * 128);
                    f32x4 r0 = (f32x4){(float)(g.x & 255u), (float)((g.x >> 8) & 255u), (float)((g.x >> 16) & 255u), (float)(g.x >> 24)} * v0, r1 = (f32x4){(float)(g.y & 255u), (float)((g.y >> 8) & 255u), (float)((g.y >> 16) & 255u), (float)(g.y >> 24)} * v1;
                    if (half) { const v4u t = *(const v4u*)(T + off + bj * 128); r0 += (f32x4){bf_lo(t.x), bf_hi(t.x), bf_lo(t.y), bf_hi(t.y)}; r1 += (f32x4){bf_lo(t.z), bf_hi(t.z), bf_lo(t.w), bf_hi(t.w)}; }
                    v4u w; w.x = cvt_pk_bf16(r0[0], r0[1]); w.y = cvt_pk_bf16(r0[2], r0[3]); w.z = cvt_pk_bf16(r1[0], r1[1]); w.w = cvt_pk_bf16(r1[2], r1[3]);
                    *(v4u*)(T + off + bj * 128) = w; } }
    }
};
struct EpiOut {
    const float* xp; const float* xs; float* out; const float* mod; const float* ms; const float* swo;
    __device__ __forceinline__ void operator()(const pg8::i32x4 (&acc)[2][2][4][2], const Unit& u, int wr, int wc, int fr, int fq) const {
        asm volatile("" : "+v"(fr), "+v"(fq));
        const int row0 = u.pm * 256 + wr * 64 + fr, col0 = u.pn * 256 + wc * 32 + 8 * fq;
        const int s = seq_of(u.pm * 256);
        const float* xb = u.pm < TP / 256 ? xp : xs - (size_t)TP * D;
        f32x4 g[2][2];
#pragma unroll
        for (int bj = 0; bj < 2; ++bj)
#pragma unroll
            for (int n = 0; n < 2; ++n) g[bj][n] = *(const f32x4*)(mod + (size_t)s * MODW + 2 * D + col0 + bj * 128 + 4 * n) * *(const f32x4*)(swo + col0 + bj * 128 + 4 * n);
#pragma unroll
        for (int ai = 0; ai < 2; ++ai)
#pragma unroll
            for (int m = 0; m < 4; ++m) { const int row = row0 + ai * 128 + m * 16; const size_t off = (size_t)row * D + col0; const float mr = ms[row];
#pragma unroll
                for (int bj = 0; bj < 2; ++bj)
#pragma unroll
                    for (int n = 0; n < 2; ++n) { const f32x4 xv = *(const f32x4*)(xb + off + bj * 128 + 4 * n); const pg8::i32x4 ia = acc[ai][bj][m][n];
                        *(f32x4*)(out + off + bj * 128 + 4 * n) = xv + g[bj][n] * ((f32x4){(float)ia[0], (float)ia[1], (float)ia[2], (float)ia[3]} * mr); } }
    }
};
struct EpiGU {
    unsigned char* ACT; const float* xs; const float* sgu;
    __device__ __forceinline__ void operator()(const pg8::i32x4 (&acc)[2][2][4][2], const Unit& u, int wr, int wc, int fr, int fq) const {
        const int row0 = u.pm * 256 + wr * 64 + fr, col0 = u.pn * 128 + wc * 32 + 8 * fq;
        const float* sp = sgu + (size_t)(u.aux * 22 + u.pn) * 256 + wc * 32 + 8 * fq;
        const f32x4 sg0 = *(const f32x4*)sp, sg1 = *(const f32x4*)(sp + 4), su0 = *(const f32x4*)(sp + 128), su1 = *(const f32x4*)(sp + 132);
#pragma unroll
        for (int ai = 0; ai < 2; ++ai)
#pragma unroll
            for (int m = 0; m < 4; ++m) { const int row = row0 + ai * 128 + m * 16; const float xr = xs[row]; unsigned char* rowp = ACT + (size_t)row * FF + col0;
                const pg8::i32x4 gi0 = acc[ai][0][m][0], gi1 = acc[ai][0][m][1], ui0 = acc[ai][1][m][0], ui1 = acc[ai][1][m][1];
                const f32x4 g0 = {(float)gi0[0], (float)gi0[1], (float)gi0[2], (float)gi0[3]}, g1 = {(float)gi1[0], (float)gi1[1], (float)gi1[2], (float)gi1[3]};
                const f32x4 u0 = {(float)ui0[0], (float)ui0[1], (float)ui0[2], (float)ui0[3]}, u1 = {(float)ui1[0], (float)ui1[1], (float)ui1[2], (float)ui1[3]};
                const f32x4 a0 = g0 * sg0 * xr, a1 = g1 * sg1 * xr, b0 = u0 * su0 * xr, b1 = u1 * su1 * xr; v2u w; unsigned t = 0u;
                t = __builtin_amdgcn_cvt_pk_fp8_f32(a0[0] * sigmoid_f(a0[0]) * b0[0], a0[1] * sigmoid_f(a0[1]) * b0[1], t, false); t = __builtin_amdgcn_cvt_pk_fp8_f32(a0[2] * sigmoid_f(a0[2]) * b0[2], a0[3] * sigmoid_f(a0[3]) * b0[3], t, true); w.x = t;
                t = __builtin_amdgcn_cvt_pk_fp8_f32(a1[0] * sigmoid_f(a1[0]) * b1[0], a1[1] * sigmoid_f(a1[1]) * b1[1], t, false); t = __builtin_amdgcn_cvt_pk_fp8_f32(a1[2] * sigmoid_f(a1[2]) * b1[2], a1[3] * sigmoid_f(a1[3]) * b1[3], t, true); w.y = t;
                *(v2u*)rowp = w; }
    }
};
constexpr float Y_SCALE = 16.0f;
struct EpiDown {
    bf16_t* Y; const float* selw; const float* wsc;
    __device__ __forceinline__ void operator()(const f32x4 (&acc)[2][2][4][2], const Unit& u, int wr, int wc, int fr, int fq) const {
        const int row0 = u.pm * 256 + wr * 64 + fr, col0 = u.pn * 256 + wc * 32 + 8 * fq; const float* cp = wsc + (size_t)u.aux * D + col0; f32x4 cs[2][2];
#pragma unroll
        for (int bj = 0; bj < 2; ++bj) { cs[bj][0] = *(const f32x4*)(cp + bj * 128); cs[bj][1] = *(const f32x4*)(cp + bj * 128 + 4); }
#pragma unroll
        for (int ai = 0; ai < 2; ++ai)
#pragma unroll
            for (int m = 0; m < 4; ++m) { const int row = row0 + ai * 128 + m * 16; const float wv = selw[row] * Y_SCALE; unsigned char* rowp = (unsigned char*)Y + (size_t)row * D + col0;
#pragma unroll
                for (int bj = 0; bj < 2; ++bj) { const f32x4 v0 = acc[ai][bj][m][0] * cs[bj][0] * wv, v1 = acc[ai][bj][m][1] * cs[bj][1] * wv; v2u w; unsigned t = 0u;
#define YC(x) __builtin_amdgcn_fmed3f((x), -448.0f, 448.0f)
                    t = __builtin_amdgcn_cvt_pk_fp8_f32(YC(v0[0]), YC(v0[1]), t, false); t = __builtin_amdgcn_cvt_pk_fp8_f32(YC(v0[2]), YC(v0[3]), t, true); w.x = t;
                    t = __builtin_amdgcn_cvt_pk_fp8_f32(YC(v1[0]), YC(v1[1]), t, false); t = __builtin_amdgcn_cvt_pk_fp8_f32(YC(v1[2]), YC(v1[3]), t, true); w.y = t;
#undef YC
                    *(v2u*)(rowp + bj * 128) = w; } }
    }
};

struct SchedGrid {
    const char* A; const char* B; size_t tstep; int nM, nN, G, c;
    __device__ __forceinline__ bool next(int i, Unit& u) const { const long L = (long)i * G + c; if (L >= (long)nM * nN) return false;
        int pm, pn; pg8::tile_of((int)L, nM, nN, pm, pn); u.pm = pm; u.pn = pn; u.aux = 0; u.idx = nullptr; u.a = A + (size_t)pm * tstep; u.b = B + (size_t)pn * tstep; return true; }
};
struct SchedGridMap {
    const char* A; const char* B; size_t tstep; int nM, nN, G, c, split, ofs0, ofs1;
    __device__ __forceinline__ bool next(int i, Unit& u) const { const long L = (long)i * G + c; if (L >= (long)nM * nN) return false;
        int pm, pj; pg8::tile_of((int)L, nM, nN, pm, pj); const int pn = pj < split ? pj + ofs0 : pj + ofs1; u.pm = pm; u.pn = pn; u.aux = 0; u.a = A + (size_t)pm * tstep; u.b = B + (size_t)pn * tstep; return true; }
};
struct SchedPair {
    const char *A0, *A1, *B0, *B1; size_t tstep; int nM, nN, G, c;
    __device__ __forceinline__ bool next(int i, Unit& u) const { const long L = (long)(i >> 1) * G + c; if (L >= (long)nM * nN) return false;
        int pm, pn; pg8::tile_of((int)L, nM, nN, pm, pn); u.pm = pm; u.pn = pn; u.aux = i & 1;
        u.a = ((i & 1) ? A1 : A0) + (size_t)pm * tstep; u.b = ((i & 1) ? B1 : B0) + (size_t)pn * tstep; return true; }
};
struct SchedMoe {
    const char* A; const char* B; size_t atstep, btstep; int NT, G, c; const int* idx;
    __device__ __forceinline__ bool next(int i, Unit& u) const { const long L = (long)i * G + c; const int per = 24 * NT; if (L >= (long)NE * per) return false;
        const int e = (int)(L / per), r = (int)(L % per), mt = r % 24, nt = r / 24;
        const int pm = mt < 8 ? e * 8 + mt : 128 + e * 16 + (mt - 8);
        u.pm = pm; u.pn = nt; u.aux = e; u.idx = idx ? idx + pm * 256 : nullptr; u.a = idx ? A : A + (size_t)pm * atstep; u.b = B + (size_t)(e * NT + nt) * btstep; return true; }
};

typedef short bf16x8_t __attribute__((ext_vector_type(8)));
typedef short s16x4_t __attribute__((ext_vector_type(4)));
typedef float f32x16 __attribute__((ext_vector_type(16)));
typedef float f32x2_t __attribute__((ext_vector_type(2)));
typedef __bf16 bf16x2_t __attribute__((ext_vector_type(2)));
__device__ __forceinline__ unsigned cvt2(float lo, float hi) { const f32x2_t v = {lo, hi}; const bf16x2_t b2 = __builtin_convertvector(v, bf16x2_t); return __builtin_bit_cast(unsigned, b2); }
constexpr int AT_KS = 272, AT_VS = 320, AT_KB = 64 * AT_KS, AT_VB = 64 * AT_VS, AT_BUF = AT_KB + AT_VB;
constexpr int AT_GQK = AUX_OFF;
__device__ __forceinline__ void attn_unit(const Frame& F, int qb, int hk) {
    const int lane = F.lane, tid = F.tid, w = F.wave, g = w >> 1, j = w & 1, c = lane & 31, h = lane >> 5, l15 = lane & 15, grp = (lane >> 4) & 1;
    const int R0 = qb * 64, s = seq_of(R0), t0 = seq_start(s), L = seq_len(s), P0 = R0 - t0, head = 4 * hk + g;
    bf16* Qb = (bf16*)(F.ws + WS_Q); const bf16* Kb = (const bf16*)((unsigned char*)F.out + DO_K); const bf16* Vb = (const bf16*)((unsigned char*)F.out + DO_V);
    const LAS float* gqk = (const LAS float*)(F.lds + AT_GQK);
    constexpr float LOG2E = 1.4426950408889634f;
    float gmax = fmaxf(fabsf(gqk[lane]), fabsf(gqk[lane + 64])); gmax = wave_max(gmax);
    const float sinkv = F.in[11][head];
    const float M2 = fmaxf(11.313708499f * gmax, sinkv) * LOG2E, slope2 = exp2f(-0.5f * (float)(head + 1)) * LOG2E;
    bf16x8_t qf[8];
    { const bf16* qrow = Qb + (size_t)(R0 + 32 * j + c) * D + head * 128 + 8 * h;
#pragma unroll
      for (int ks = 0; ks < 8; ++ks) qf[ks] = __builtin_bit_cast(bf16x8_t, *(const v4u*)(qrow + 16 * ks)); }
    f32x16 o[4];
#pragma unroll
    for (int dt = 0; dt < 4; ++dt)
#pragma unroll
        for (int i = 0; i < 16; ++i) o[dt][i] = 0.f;
    float lsum = 0.f;
    const int c_lo = P0 >= 128 ? 0 : (P0 >= 64 ? 1 : 2), c_hi = (P0 + 192 <= L) ? 4 : ((P0 + 128 <= L) ? 3 : 2);
    LAS unsigned char* ring = F.lds + RING_OFF;
    v4u kr[2], vr[2];
#define AT_LOAD(cc) do { const int kp = P0 - 128 + 64 * (cc); _Pragma("unroll") for (int i = 0; i < 2; ++i) { const int p = tid + 512 * i; const size_t off = (size_t)(t0 + kp + (p >> 4)) * KVW + hk * 128 + (p & 15) * 8; \
        kr[i] = *(const v4u*)(Kb + off); vr[i] = *(const v4u*)(Vb + off); } } while (0)
#define AT_WRITE(bufi) do { LAS unsigned char* kb_ = ring + (bufi) * AT_BUF; LAS unsigned char* vb_ = kb_ + AT_KB; _Pragma("unroll") for (int i = 0; i < 2; ++i) { const int p = tid + 512 * i, key = p >> 4, dd = (p & 15) * 8; \
        *(LAS v4u*)(kb_ + key * AT_KS + dd * 2) = kr[i]; *(LAS v4u*)(vb_ + key * AT_VS + dd * 2) = vr[i]; } } while (0)
    AT_LOAD(c_lo); AT_WRITE(0);
    __syncthreads();
    for (int cc = c_lo; cc <= c_hi; ++cc) {
        const int bi = (cc - c_lo) & 1;
        if (cc < c_hi) AT_LOAD(cc + 1);
        const LAS unsigned char* kbuf = ring + bi * AT_BUF; const LAS unsigned char* vbuf = kbuf + AT_KB;
#pragma unroll
        for (int u = 0; u < 2; ++u) {
            const int tt = 2 * cc + u;
            if (tt >= j && tt <= j + 8) {
                const int d0 = -128 + 32 * (tt - j);
                f32x16 sacc;
#pragma unroll
                for (int i = 0; i < 16; ++i) sacc[i] = 0.f;
#pragma unroll
                for (int ks = 0; ks < 8; ++ks) { const bf16x8_t kf = *(const LAS bf16x8_t*)(kbuf + (32 * u + c) * AT_KS + (16 * ks + 8 * h) * 2);
                    sacc = __builtin_amdgcn_mfma_f32_32x32x16_bf16(kf, qf[ks], sacc, 0, 0, 0); }
                const float relb = (float)(d0 - c + 4 * h); const int keyb = 4 * h;
                unsigned pk[8];
#pragma unroll
                for (int i2 = 0; i2 < 8; ++i2) { float pe[2];
#pragma unroll
                    for (int q = 0; q < 2; ++q) { const int i = 2 * i2 + q, ko = (i & 3) + 8 * (i >> 2);
                        float v = __builtin_amdgcn_exp2f(sacc[i] - slope2 * fabsf(relb + (float)ko) - M2);
                        if (d0 == -128) v = (keyb + ko >= c) ? v : 0.f;
                        if (d0 == 128) v = (keyb + ko <= c) ? v : 0.f;
                        lsum += v; pe[q] = v; }
                    pk[i2] = cvt2(pe[0], pe[1]); }
                const bf16x8_t pf0 = __builtin_bit_cast(bf16x8_t, (v4u){pk[0], pk[1], pk[2], pk[3]}), pf1 = __builtin_bit_cast(bf16x8_t, (v4u){pk[4], pk[5], pk[6], pk[7]});
                const LAS unsigned char* vrow = vbuf + (32 * u + 4 * h + (l15 >> 2)) * AT_VS + (16 * grp) * 2 + (l15 & 3) * 8;
#pragma unroll
                for (int dt = 0; dt < 4; ++dt) {
#pragma unroll
                    for (int sx = 0; sx < 2; ++sx) { const LAS unsigned char* vp = vrow + (16 * sx) * AT_VS + dt * 64;
                        const s16x4_t lo = __builtin_bit_cast(s16x4_t, __builtin_amdgcn_ds_read_tr16_b64_v4i16((LAS s16x4_t*)vp));
                        const s16x4_t hi = __builtin_bit_cast(s16x4_t, __builtin_amdgcn_ds_read_tr16_b64_v4i16((LAS s16x4_t*)(vp + 8 * AT_VS)));
                        const bf16x8_t vf = {lo[0], lo[1], lo[2], lo[3], hi[0], hi[1], hi[2], hi[3]};
                        o[dt] = __builtin_amdgcn_mfma_f32_32x32x16_bf16(vf, sx ? pf1 : pf0, o[dt], 0, 0, 0); } }
            }
        }
        if (cc < c_hi) AT_WRITE(bi ^ 1);
        __syncthreads();
    }
#undef AT_LOAD
#undef AT_WRITE
    lsum += __shfl_xor(lsum, 32);
    const float inv = 1.0f / (lsum + __builtin_amdgcn_exp2f(sinkv * LOG2E - M2));
    unsigned char* orow = F.ws + WS_ATT8 + (size_t)(R0 + 32 * j + c) * D + head * 128 + 4 * h;
#pragma unroll
    for (int dt = 0; dt < 4; ++dt)
#pragma unroll
        for (int gi = 0; gi < 4; ++gi) { unsigned t = 0u; t = __builtin_amdgcn_cvt_pk_fp8_f32(o[dt][4 * gi] * inv, o[dt][4 * gi + 1] * inv, t, false); t = __builtin_amdgcn_cvt_pk_fp8_f32(o[dt][4 * gi + 2] * inv, o[dt][4 * gi + 3] * inv, t, true);
            *(unsigned*)(orow + 32 * dt + 8 * gi) = t; }
}
constexpr int SG_VS = 320, SG_WS = 272, SG_MS = 272, SG_VN = 0, SG_W = 128 * SG_VS, SG_MIX = SG_W + 128 * SG_WS;
__device__ __forceinline__ void sgu_unit(const Frame& F, int chunk, int gquad) {
    LAS unsigned char* ring = F.lds + RING_OFF;
    LAS float* st = (LAS float*)(F.lds + AUX_OFF + 1024);
    bf16* U = (bf16*)(F.ws + WS_U); const bf16* VG = (const bf16*)(F.ws + WS_VG); const bf16* SW = (const bf16*)(F.ws + WS_SGW);
    const float* vst = (const float*)((unsigned char*)F.out + DO_VST);
    const float* lng = F.in[12]; const float* lnb = F.in[13]; const float* sb = F.in[15];
    const int row0 = chunk * 128, tid = F.tid, lane = F.lane, w = F.wave, c31 = lane & 31, h = lane >> 5, l15 = lane & 15, grp = (lane >> 4) & 1;
    { const int r = tid >> 2, q = tid & 3; const f32x4* p = (const f32x4*)(vst + ((size_t)(row0 + r) * 32 + q * 8) * 2); float s1 = 0.f, s2 = 0.f;
#pragma unroll
      for (int i = 0; i < 4; ++i) { const f32x4 x = p[i]; s1 += x.x + x.z; s2 += x.y + x.w; }
      s1 += __shfl_xor(s1, 1); s1 += __shfl_xor(s1, 2); s2 += __shfl_xor(s2, 1); s2 += __shfl_xor(s2, 2);
      const float mean = s1 * (1.0f / D), var = fmaxf(s2 * (1.0f / D) - mean * mean, 0.f);
      if (q == 0) { st[2 * r] = mean; st[2 * r + 1] = 1.0f / sqrtf(var + NORM_EPS); } }
    __syncthreads();
    const int sr = tid >> 4, sc = (tid & 15) * 8;
    const int ct = w & 3, th = w >> 2;
    for (int gi = 0; gi < 4; ++gi) {
        const int g = gquad * 4 + gi;
        v4u xv[4], wv[4], uv[4];
#pragma unroll
        for (int q = 0; q < 4; ++q) { const int r = sr + 32 * q; xv[q] = *(const v4u*)(VG + (size_t)(row0 + r) * D + g * 128 + sc); wv[q] = *(const v4u*)(SW + (size_t)g * 16384 + r * 128 + sc);
            uv[q] = *(const v4u*)(U + (size_t)(row0 + r) * D + g * 128 + sc); }
        { const f32x4 ga = *(const f32x4*)(lng + g * 128 + sc), gb = *(const f32x4*)(lng + g * 128 + sc + 4), ba = *(const f32x4*)(lnb + g * 128 + sc), bb = *(const f32x4*)(lnb + g * 128 + sc + 4);
#pragma unroll
          for (int q = 0; q < 4; ++q) { const int r = sr + 32 * q; const float mean = st[2 * r], rstd = st[2 * r + 1]; const v4u x = xv[q];
              const f32x4 fa = {bf_lo(x.x), bf_hi(x.x), bf_lo(x.y), bf_hi(x.y)}, fb = {bf_lo(x.z), bf_hi(x.z), bf_lo(x.w), bf_hi(x.w)};
              const f32x4 ya = (fa - mean) * rstd * ga + ba, yb = (fb - mean) * rstd * gb + bb;
              v4u o; o.x = cvt2(ya.x, ya.y); o.y = cvt2(ya.z, ya.w); o.z = cvt2(yb.x, yb.y); o.w = cvt2(yb.z, yb.w);
              *(LAS v4u*)(ring + SG_VN + r * SG_VS + sc * 2) = o; *(LAS v4u*)(ring + SG_W + r * SG_WS + sc * 2) = wv[q]; } }
        __syncthreads();
        f32x16 acc[2];
#pragma unroll
        for (int x = 0; x < 2; ++x)
#pragma unroll
            for (int i = 0; i < 16; ++i) acc[x][i] = 0.f;
        { const LAS unsigned char* vrow = ring + SG_VN + (8 * h + (l15 >> 2)) * SG_VS + (32 * ct + 16 * grp) * 2 + (l15 & 3) * 8;
          const LAS unsigned char* wrow = ring + SG_W + (64 * th + c31) * SG_WS + (8 * h) * 2;
#pragma unroll
          for (int ks = 0; ks < 8; ++ks) {
              const s16x4_t lo = __builtin_bit_cast(s16x4_t, __builtin_amdgcn_ds_read_tr16_b64_v4i16((LAS s16x4_t*)(vrow + (16 * ks) * SG_VS)));
              const s16x4_t hi = __builtin_bit_cast(s16x4_t, __builtin_amdgcn_ds_read_tr16_b64_v4i16((LAS s16x4_t*)(vrow + (16 * ks + 4) * SG_VS)));
              const bf16x8_t af = {lo[0], lo[1], lo[2], lo[3], hi[0], hi[1], hi[2], hi[3]};
#pragma unroll
              for (int x = 0; x < 2; ++x) { const bf16x8_t bfr = *(const LAS bf16x8_t*)(wrow + (32 * x) * SG_WS + (16 * ks) * 2);
                  acc[x] = __builtin_amdgcn_mfma_f32_32x32x16_bf16(af, bfr, acc[x], 0, 0, 0); } } }
#pragma unroll
        for (int x = 0; x < 2; ++x) { const int t = 64 * th + 32 * x + c31; const float bias = sb[g * 128 + t];
#pragma unroll
            for (int q4 = 0; q4 < 4; ++q4) { v2u o; o.x = cvt2(acc[x][4 * q4] + bias, acc[x][4 * q4 + 1] + bias); o.y = cvt2(acc[x][4 * q4 + 2] + bias, acc[x][4 * q4 + 3] + bias);
                *(LAS v2u*)(ring + SG_MIX + t * SG_MS + (32 * ct + 8 * q4 + 4 * h) * 2) = o; } }
        __syncthreads();
#pragma unroll
        for (int q = 0; q < 4; ++q) { const int r = sr + 32 * q; const v4u m8 = *(const LAS v4u*)(ring + SG_MIX + r * SG_MS + sc * 2); const v4u u8 = uv[q]; v4u o;
            o.x = cvt2(bf_lo(u8.x) * bf_lo(m8.x), bf_hi(u8.x) * bf_hi(m8.x)); o.y = cvt2(bf_lo(u8.y) * bf_lo(m8.y), bf_hi(u8.y) * bf_hi(m8.y));
            o.z = cvt2(bf_lo(u8.z) * bf_lo(m8.z), bf_hi(u8.z) * bf_hi(m8.z)); o.w = cvt2(bf_lo(u8.w) * bf_lo(m8.w), bf_hi(u8.w) * bf_hi(m8.w));
            *(v4u*)(U + (size_t)(row0 + r) * D + g * 128 + sc) = o; }
    }
    __syncthreads();
}

template <int PER> __device__ __forceinline__ void topk_body(const Frame& F, int g, int e) {
    constexpr int T = PER * 512, C = T / 8; const int tid = F.tid, lane = F.lane, w = F.wave;
    const float* vals = (const float*)(F.ws + WS_AFFT) + (g ? (size_t)NE * TP + (size_t)e * TS : (size_t)e * TP);
    LAS unsigned* lv = (LAS unsigned*)(F.lds + RING_OFF);
    LAS unsigned* red = (LAS unsigned*)(F.lds + AUX_OFF + 8192);
    LAS unsigned* cg = red + 64; LAS unsigned* ce = red + 64 + 520;
    for (int i = tid; i < T; i += 512) lv[i + (i >> 5)] = __float_as_uint(vals[i]);
    __syncthreads();
    unsigned v[PER]; const int i0 = tid * PER;
#pragma unroll
    for (int i = 0; i < PER; ++i) v[i] = lv[i0 + i + ((i0 + i) >> 5)];
    unsigned prefix = 0u;
    for (int bit = 30; bit >= 0; --bit) {
        const unsigned cand = prefix | (1u << bit); unsigned cnt = 0u;
#pragma unroll
        for (int i = 0; i < PER; ++i) cnt += (v[i] >= cand) ? 1u : 0u;
        cnt = (unsigned)wave_sum_i((int)cnt);
        LAS unsigned* rb = red + (bit & 1) * 8;
        if (lane == 0) rb[w] = cnt;
        __syncthreads();
        const unsigned tot = (rb[0] + rb[1]) + (rb[2] + rb[3]) + ((rb[4] + rb[5]) + (rb[6] + rb[7]));
        if (tot >= (unsigned)C) prefix = cand;
    }
    const unsigned thr = prefix;
    unsigned ng = 0u, ne = 0u;
#pragma unroll
    for (int i = 0; i < PER; ++i) { ng += (v[i] > thr) ? 1u : 0u; ne += (v[i] == thr) ? 1u : 0u; }
    __syncthreads();
    cg[tid] = ng; ce[tid] = ne;
    __syncthreads();
    if (w == 0) {
        unsigned a[8], b[8], sa = 0u, sb2 = 0u;
#pragma unroll
        for (int i = 0; i < 8; ++i) { a[i] = cg[lane * 8 + i]; b[i] = ce[lane * 8 + i]; sa += a[i]; sb2 += b[i]; }
        unsigned pa = sa, pb = sb2;
#pragma unroll
        for (int o = 1; o < 64; o <<= 1) { const unsigned ta = __shfl_up(pa, o), tb = __shfl_up(pb, o); if (lane >= o) { pa += ta; pb += tb; } }
        unsigned ea = pa - sa, eb = pb - sb2;
#pragma unroll
        for (int i = 0; i < 8; ++i) { cg[lane * 8 + i] = ea; ce[lane * 8 + i] = eb; ea += a[i]; eb += b[i]; }
        if (lane == 63) { cg[512] = pa; }
    }
    __syncthreads();
    const unsigned gb = cg[tid]; unsigned eb = ce[tid]; const unsigned k = (unsigned)C - cg[512];
    int* seli = (int*)(F.ws + WS_SELI); float* selw = (float*)(F.ws + WS_SELW); int* inv = (int*)(F.ws + WS_INV); const float* hs = (const float*)(F.ws + WS_HS); float* xs = (float*)(F.ws + WS_XS);
    const int sbase = g ? NE * CAP_P + e * CAP_S : e * CAP_P, rbase = g ? TP : 0;
    LAS unsigned* mlo = (LAS unsigned*)(F.lds + AUX_OFF + 4096); LAS unsigned* mhi = mlo + 512;
    { const unsigned slot0 = gb + (eb < k ? eb : k); unsigned lo = 0u, hi = 0u;
#pragma unroll
      for (int i = 0; i < PER; ++i) { const bool gt = v[i] > thr, eq = v[i] == thr, sel = gt || (eq && eb < k); eb += eq ? 1u : 0u; if (i < 32) lo |= sel ? (1u << (i & 31)) : 0u; else hi |= sel ? (1u << (i & 31)) : 0u; }
      mlo[tid] = lo; mhi[tid] = hi; cg[tid] = slot0; }
    __syncthreads();
#pragma unroll 4
    for (int i = 0; i < PER; ++i) { const int idx = i * 512 + tid, own = idx / PER, bit = idx % PER; const unsigned u = lv[idx + (idx >> 5)];
        const unsigned lo = mlo[own], hi = mhi[own]; const unsigned long long mk = ((unsigned long long)hi << 32) | lo; const bool sel = (mk >> bit) & 1ull;
        const int below = __popcll(mk & ((1ull << bit) - 1ull)), slot = sel ? (int)cg[own] + below : -1, row = rbase + idx; const float hrow = hs[row];
        inv[(size_t)row * NE + e] = slot;
        if (sel) { seli[sbase + slot] = row; selw[sbase + slot] = __uint_as_float(u); xs[sbase + slot] = hrow; } }
    __syncthreads();
}
__device__ __forceinline__ void topk_task(const Frame& F, int task) {
    const int g = task >> 4, e = task & 15;
    if (g) topk_body<TS / 512>(F, 1, e); else topk_body<TP / 512>(F, 0, e);
}

__global__ void __launch_bounds__(NWAVES * 64, 2) fwd_kernel(Args args) {
    extern __shared__ __attribute__((aligned(16))) unsigned char lds[];
    Frame F;
    F.lds = (LAS unsigned char*)lds;
    F.tid = threadIdx.x; F.lane = F.tid & 63; F.wave = __builtin_amdgcn_readfirstlane(F.tid >> 6);
    F.G = gridDim.x; { const int bx = blockIdx.x; F.vcu = (F.G % 8 == 0) ? (bx % 8) * (F.G / 8) + bx / 8 : bx; }
    F.in = args.in; F.out = args.out; F.ws = args.ws;
    volatile LAS unsigned* MISC = (volatile LAS unsigned*)(F.lds + MISC_OFF);
    if (F.tid < 64) MISC[F.tid] = 0u;
    __syncthreads();
    unsigned* ctl = (unsigned*)(F.ws + WS_CTL);
    XcdBarrier bar; bar.bar = ctl + CW_BAR; bar.x = 0; bar.st = nullptr; bar.wave = F.wave;
    if (!MK_PER_PHASE) bar = xcd_barrier_post(ctl + CW_BAR, MISC + 8);
    const int lo = args.ph_lo, hi = args.ph_hi;
#define IN(k) (lo <= (k) && (k) < hi)
#define REPS(k) (((PROBE_MASK >> (k)) & 1) ? 2 : 1)
#define SEAM(k) do { if (IN(k) && IN((k) + 1)) xcd_barrier(bar); } while (0)
    const int gw = F.vcu * NWAVES + F.wave, NGW = F.G * NWAVES;
    unsigned char* const ws = F.ws; unsigned char* const ob = (unsigned char*)F.out;

    if (IN(0)) { for (int rep = 0; rep < REPS(0); ++rep) p0_prologue(F); } SEAM(0);
    F.lane = fresh_lane(); F.tid = F.lane + (F.wave << 6);
    if (IN(1)) { for (int rep = 0; rep < REPS(1); ++rep) p1_rows(F); } SEAM(1);
    if (IN(2)) {
        SchedGrid S{(const char*)(ws + WS_H1Q), (const char*)(ws + WS_WIN8), (size_t)256 * D, M / 256, IN_W / 256, F.G, (int)blockIdx.x};
        EpiGate E{(bf16_t*)(ws + WS_Q), (bf16_t*)(ob + DO_K), (bf16_t*)(ob + DO_V), (bf16_t*)(ws + WS_U), (bf16_t*)(ws + WS_VG), (bf16_t*)(ws + WS_GS), (bf16_t*)(ws + WS_GS + (size_t)M * D), (float*)(ob + DO_VST), (const float*)(ws + WS_HS1), (const float*)(ws + WS_SWIN), F.in[9], F.in[10], (LAS float*)(F.lds + AUX_OFF)};
        pg8::gemm_phase<EpiGate, SchedGrid, true, true, 1>(F.lds + RING_OFF, D, D, D / 128, S, E, F.wave);
    } SEAM(2);
    F.lane = fresh_lane(); F.tid = F.lane + (F.wave << 6);
    if (IN(3)) {
        for (int n = F.vcu; n < (M / 128) * 4; n += F.G) sgu_unit(F, n >> 2, n & 3);
        if (F.tid < 128) ((LAS float*)(F.lds + AT_GQK))[F.tid] = F.in[9][F.tid] * F.in[10][F.tid];
        __syncthreads();
        for (int n = F.vcu; n < (M / 64) * 4; n += F.G) attn_unit(F, n >> 2, n & 3);
    } SEAM(3);
    if (IN(4)) {
        { SchedGrid S{(const char*)(ws + WS_ATT8), (const char*)(ws + WS_WOA8), (size_t)256 * D, M / 256, D / 256, F.G, (int)blockIdx.x};
          EpiMerge E{(bf16_t*)(ws + WS_GA), ws + WS_GS, (const float*)(ws + WS_WSCO), 0};
          pg8::gemm_phase<EpiMerge, SchedGrid, true, true, 2>(F.lds + RING_OFF, D, D, D / 128, S, E, F.wave); }
        { SchedGrid S{(const char*)(ws + WS_U), (const char*)(ws + WS_WOS), (size_t)256 * D * 2, M / 256, D / 256, F.G, (int)blockIdx.x};
          EpiMerge E{(bf16_t*)(ws + WS_GA), ws + WS_GS + (size_t)M * D, (const float*)(ws + WS_WSCO), 1};
          pg8::gemm_phase<EpiMerge, SchedGrid, true, true>(F.lds + RING_OFF, D * 2, D * 2, D / 64, S, E, F.wave); }
    } SEAM(4);
    F.lane = fresh_lane(); F.tid = F.lane + (F.wave << 6);
    if (IN(5)) {
        const bf16* mg = (const bf16*)(ws + WS_GA); unsigned* mq = (unsigned*)(ws + WS_MQ); float* msc = (float*)(ws + WS_MS);
        for (int m = gw; m < M; m += NGW) { const v4u* src = (const v4u*)(mg + (size_t)m * D) + F.lane; v4u x[4]; float amax = 0.f;
#pragma unroll
            for (int j = 0; j < 4; ++j) { x[j] = src[64 * j];
                amax = fmaxf(amax, fmaxf(fmaxf(fmaxf(fabsf(bf_lo(x[j].x)), fabsf(bf_hi(x[j].x))), fmaxf(fabsf(bf_lo(x[j].y)), fabsf(bf_hi(x[j].y)))), fmaxf(fmaxf(fabsf(bf_lo(x[j].z)), fabsf(bf_hi(x[j].z))), fmaxf(fabsf(bf_lo(x[j].w)), fabsf(bf_hi(x[j].w)))))); }
            amax = wave_max(amax); const float inv = amax > 0.f ? 127.0f / amax : 0.f; v2u* dst = (v2u*)(mq + (size_t)m * (D / 4)) + F.lane;
#pragma unroll
            for (int j = 0; j < 4; ++j) { v2u o; o.x = q8x4(bf_lo(x[j].x), bf_hi(x[j].x), bf_lo(x[j].y), bf_hi(x[j].y), inv); o.y = q8x4(bf_lo(x[j].z), bf_hi(x[j].z), bf_lo(x[j].w), bf_hi(x[j].w), inv); dst[64 * j] = o; }
            if (F.lane == 0) msc[m] = amax * (1.0f / 127.0f); }
        if (!MK_PER_PHASE) xcd_barrier(bar);
    }
    if (IN(5)) {
        SchedGrid S{(const char*)(ws + WS_MQ), (const char*)(ws + WS_WOUT), (size_t)256 * D, M / 256, D / 256, F.G, (int)blockIdx.x};
        EpiOut E{F.in[0], F.in[1], F.out, (const float*)(ws + WS_MOD), (const float*)(ws + WS_MS), (const float*)(ws + WS_SWO)};
        pg8::gemm_phase<EpiOut, SchedGrid, true, true, 1>(F.lds + RING_OFF, D, D, D / 128, S, E, F.wave);
    } SEAM(5);
    F.lane = fresh_lane(); F.tid = F.lane + (F.wave << 6);
    if (IN(6)) { for (int rep = 0; rep < REPS(6); ++rep) p6_rows(F); } SEAM(6);
    F.lane = fresh_lane(); F.tid = F.lane + (F.wave << 6);
    if (IN(7)) for (int rep = 0; rep < REPS(7); ++rep) { for (int task = blockIdx.x; task < 2 * NE; task += F.G) topk_task(F, task); } SEAM(7);
    if (IN(9)) {
        SchedMoe S{(const char*)(ws + WS_Q), (const char*)(ws + WS_WGU), (size_t)256 * D, (size_t)256 * D, FF / 128, F.G, (int)blockIdx.x, (const int*)(ws + WS_SELI)};
        EpiGU E{ws + WS_ACT, (const float*)(ws + WS_XS), (const float*)(ws + WS_SGU)};
        pg8::gemm_phase<EpiGU, SchedMoe, true, true, 1, true>(F.lds + RING_OFF, D, D, D / 128, S, E, F.wave);
    }
    if (IN(9) && REPS(9) == 2) {
        SchedMoe S{(const char*)(ws + WS_Q), (const char*)(ws + WS_WGU), (size_t)256 * D, (size_t)256 * D, FF / 128, F.G, (int)blockIdx.x, (const int*)(ws + WS_SELI)};
        EpiGU E{ws + WS_ACT, (const float*)(ws + WS_XS), (const float*)(ws + WS_SGU)};
        pg8::gemm_phase<EpiGU, SchedMoe, true, true, 1, true>(F.lds + RING_OFF, D, D, D / 128, S, E, F.wave);
    } SEAM(9);
    if (IN(10)) {
        SchedMoe S{(const char*)(ws + WS_ACT), (const char*)(ws + WS_WD), (size_t)256 * FF, (size_t)256 * FF, D / 256, F.G, (int)blockIdx.x, nullptr};
        EpiDown E{(bf16_t*)(ws + WS_XE), (const float*)(ws + WS_SELW), (const float*)(ws + WS_WSC)};
        pg8::gemm_phase<EpiDown, SchedMoe, true, true, 2>(F.lds + RING_OFF, FF, FF, FF / 128, S, E, F.wave);
    }
    if (IN(10) && REPS(10) == 2) {
        SchedMoe S{(const char*)(ws + WS_ACT), (const char*)(ws + WS_WD), (size_t)256 * FF, (size_t)256 * FF, D / 256, F.G, (int)blockIdx.x, nullptr};
        EpiDown E{(bf16_t*)(ws + WS_XE), (const float*)(ws + WS_SELW), (const float*)(ws + WS_WSC)};
        pg8::gemm_phase<EpiDown, SchedMoe, true, true, 2>(F.lds + RING_OFF, FF, FF, FF / 128, S, E, F.wave);
    } SEAM(10);
    F.lane = fresh_lane(); F.tid = F.lane + (F.wave << 6);
    if (IN(11)) {
        const int* inv = (const int*)(ws + WS_INV); const unsigned char* Y = (const unsigned char*)(ws + WS_XE); const float* mod = (const float*)(ws + WS_MOD);
        for (int m = gw; m < M; m += NGW) {
            const int s = seq_of(m), g = m < TP ? 0 : 1; const int myinv = inv[(size_t)m * NE + (F.lane & 15)];
            f32x4* op = (f32x4*)(F.out + (size_t)m * D) + F.lane; f32x4 acc[8], xv[8];
#pragma unroll
            for (int j = 0; j < 8; ++j) { acc[j] = (f32x4){0.f, 0.f, 0.f, 0.f}; xv[j] = op[64 * j]; }
            unsigned emask = (unsigned)(__ballot(myinv >= 0) & 0xFFFFull);
            while (emask) {
                const int e1 = __ffs(emask) - 1; emask &= emask - 1; const bool two = emask != 0u; const int e2 = two ? __ffs(emask) - 1 : e1; if (two) emask &= emask - 1;
                const int c1 = __shfl(myinv, e1), c2 = __shfl(myinv, e2);
                const size_t s1 = g ? (size_t)NE * CAP_P + (size_t)e1 * CAP_S + c1 : (size_t)e1 * CAP_P + c1, s2 = g ? (size_t)NE * CAP_P + (size_t)e2 * CAP_S + c2 : (size_t)e2 * CAP_P + c2;
                const unsigned* y1p = (const unsigned*)(Y + s1 * D) + F.lane; const unsigned* y2p = (const unsigned*)(Y + s2 * D) + F.lane; unsigned y1[8], y2[8];
#pragma unroll
                for (int j = 0; j < 8; ++j) { y1[j] = y1p[64 * j]; y2[j] = y2p[64 * j]; }
#pragma unroll
                for (int j = 0; j < 8; ++j) { typedef float f2_t __attribute__((ext_vector_type(2)));
                    { const f2_t lo = __builtin_amdgcn_cvt_pk_f32_fp8((int)y1[j], false), hi = __builtin_amdgcn_cvt_pk_f32_fp8((int)y1[j], true); acc[j] += (f32x4){lo.x, lo.y, hi.x, hi.y}; }
                    if (two) { const f2_t lo = __builtin_amdgcn_cvt_pk_f32_fp8((int)y2[j], false), hi = __builtin_amdgcn_cvt_pk_f32_fp8((int)y2[j], true); acc[j] += (f32x4){lo.x, lo.y, hi.x, hi.y}; } }
            }
            const f32x4* g2 = (const f32x4*)(mod + (size_t)s * MODW + 5 * D) + F.lane;
#pragma unroll
            for (int j = 0; j < 8; ++j) op[64 * j] = xv[j] + g2[64 * j] * (1.0f / Y_SCALE) * acc[j];
        }
    }
#undef IN
#undef SEAM
}


__global__ void dbg_dump(const unsigned short* q, const unsigned short* u, const unsigned short* vg, const unsigned short* ga, const unsigned short* gs, float* out, size_t n) {
    for (size_t i = (size_t)blockIdx.x * blockDim.x + threadIdx.x; i < n; i += (size_t)gridDim.x * blockDim.x) {
        out[i] = __uint_as_float((unsigned)q[i] << 16) + 2.f * __uint_as_float((unsigned)u[i] << 16) + 4.f * __uint_as_float((unsigned)vg[i] << 16) + 8.f * __uint_as_float((unsigned)ga[i] << 16) + 16.f * __uint_as_float((unsigned)gs[i] << 16); }
}

__global__ void dbg_dump2(const unsigned short* win, const unsigned short* wgu, const unsigned short* wd, const unsigned short* woa, float* out, size_t n) {
    for (size_t i = (size_t)blockIdx.x * blockDim.x + threadIdx.x; i < n; i += (size_t)gridDim.x * blockDim.x) {
        out[i] = __uint_as_float((unsigned)win[i % ((size_t)IN_W * D)] << 16) + 2.f * __uint_as_float((unsigned)wgu[i] << 16) + 4.f * __uint_as_float((unsigned)wd[i % ((size_t)NE * D * FF)] << 16) + 8.f * __uint_as_float((unsigned)woa[i % ((size_t)3 * D * D)] << 16); }
}

__device__ __forceinline__ float bf16r(float f) { unsigned u = __float_as_uint(f); u += 0x7fffu + ((u >> 16) & 1u); return __uint_as_float(u & 0xffff0000u); }
__global__ void dbg_check_gemm(const unsigned short* h1, const float* w_in, const unsigned short* Q, const unsigned short* Kb, const unsigned short* Vb, unsigned* cnt) {
    const int i = blockIdx.x * blockDim.x + threadIdx.x;
    unsigned long long z = (unsigned long long)i * 0x9E3779B97F4A7C15ull + 12345; z ^= z >> 29; z *= 0xBF58476D1CE4E5B9ull; z ^= z >> 32;
    const int m = (int)(z % M), n = (int)((z >> 20) % 3072);
    float ref = 0.f;
    for (int k = 0; k < D; ++k) ref += __uint_as_float((unsigned)h1[(size_t)m * D + k] << 16) * bf16r(w_in[(size_t)k * IN_W + n]);
    float got;
    if (n < 2048) got = __uint_as_float((unsigned)Q[(size_t)m * D + n] << 16);
    else if (n < 2560) got = __uint_as_float((unsigned)Kb[(size_t)m * KVW + n - 2048] << 16);
    else got = __uint_as_float((unsigned)Vb[(size_t)m * KVW + n - 2560] << 16);
    const float err = fabsf(got - ref);
    if (!(err <= 0.03f * (1.0f + fabsf(ref)))) { atomicAdd(cnt, 1u); if (n < 2048) atomicAdd(cnt + 1, 1u); else if (n < 2560) atomicAdd(cnt + 2, 1u); else atomicAdd(cnt + 3, 1u); if (fabsf(got) > 100.f) atomicAdd(cnt + 4, 1u); }
}
__global__ void dbg_fill(float* out, size_t n, const unsigned* cnt, int which) {
    const unsigned c = cnt[which]; const float v = c == 0 ? 0.f : c < 10 ? 1.f : c < 100 ? 2.f : c < 1000 ? 3.f : c < 10000 ? 4.f : 5.f;
    for (size_t i = (size_t)blockIdx.x * blockDim.x + threadIdx.x; i < n; i += (size_t)gridDim.x * blockDim.x) out[i] = v;
}
extern "C" void kernel_launch(void* const* d_in, const int* in_sizes, int n_in, void* d_out, int out_size, void* d_ws, size_t ws_size, hipStream_t stream) {
    static int grid = 0;
    if (grid == 0) {
        if (n_in != 23 || out_size != M * D || ws_size < WS_END) { fprintf(stderr, "kernel_launch: unexpected shapes (n_in %d, out %d, ws %zu, need %zu)\n", n_in, out_size, ws_size, (size_t)WS_END); grid = -1; return; }
        int dev = 0, cus = 0, per_cu = 0;
        if (hipGetDevice(&dev) != hipSuccess || hipDeviceGetAttribute(&cus, hipDeviceAttributeMultiprocessorCount, dev) != hipSuccess) { grid = -1; return; }
        if (hipFuncSetAttribute((const void*)fwd_kernel, hipFuncAttributeMaxDynamicSharedMemorySize, LDS_BYTES) != hipSuccess) { fprintf(stderr, "kernel_launch: hipFuncSetAttribute failed\n"); grid = -1; return; }
        if (hipOccupancyMaxActiveBlocksPerMultiprocessor(&per_cu, (const void*)fwd_kernel, NWAVES * 64, LDS_BYTES) != hipSuccess || per_cu < 1) fprintf(stderr, "kernel_launch: occupancy query says %d\n", per_cu);
        (void)hipGetLastError();
        grid = cus;
    }
    if (grid < 0) return;
    (void)hipMemsetAsync((char*)d_ws + WS_CTL, 0, CTL_ZERO_BYTES, stream);
    Args a{};
    for (int i = 0; i < 23; ++i) a.in[i] = (const float*)d_in[i];
    a.out = (float*)d_out; a.ws = (unsigned char*)d_ws;
#if MK_PER_PHASE
    for (int p = 0; p < DBG_NPH; ++p) { a.ph_lo = p; a.ph_hi = p + 1; a.li = p; hipLaunchKernelGGL(fwd_kernel, dim3(grid), dim3(NWAVES * 64), LDS_BYTES, stream, a); }
    if (DBG_NPH == 1) { unsigned char* w = (unsigned char*)d_ws; hipLaunchKernelGGL(dbg_dump2, dim3(4096), dim3(256), 0, stream, (const unsigned short*)(w + WS_WIN), (const unsigned short*)(w + WS_WGU), (const unsigned short*)(w + WS_WD), (const unsigned short*)(w + WS_WOA), (float*)d_out, (size_t)M * D); }
    else if (DBG_NPH == 3) { unsigned char* w = (unsigned char*)d_ws; unsigned* cnt = (unsigned*)(w + 512 * 1024);
        hipLaunchKernelGGL(dbg_check_gemm, dim3(256), dim3(256), 0, stream, (const unsigned short*)(w + WS_WGU), (const float*)d_in[8], (const unsigned short*)(w + WS_Q), (const unsigned short*)((unsigned char*)d_out + DO_K), (const unsigned short*)((unsigned char*)d_out + DO_V), cnt);
        hipLaunchKernelGGL(dbg_fill, dim3(4096), dim3(256), 0, stream, (float*)d_out, (size_t)M * D, (const unsigned*)cnt, DBG_WHICH); }
    else if (DBG_NPH < 6) { unsigned char* w = (unsigned char*)d_ws; hipLaunchKernelGGL(dbg_dump, dim3(4096), dim3(256), 0, stream, (const unsigned short*)(w + WS_Q), (const unsigned short*)(w + WS_U), (const unsigned short*)(w + WS_VG), (const unsigned short*)(w + WS_GA), (const unsigned short*)(w + WS_GS), (float*)d_out, (size_t)M * D); }
#else
    a.ph_lo = 0; a.ph_hi = NPHASE; a.li = 0; hipLaunchKernelGGL(fwd_kernel, dim3(grid), dim3(NWAVES * 64), LDS_BYTES, stream, a);
#endif
}
```

```cpp
#include <hip/hip_runtime.h>
#include <cstdio>
#include <cstdint>

#ifndef MK_PER_PHASE
#define MK_PER_PHASE 0
#endif
#ifndef PROBE_MASK
#define PROBE_MASK 0
#endif
#ifndef DBG_WHICH
#define DBG_WHICH 0
#endif
#ifndef DBG_NPH
#define DBG_NPH 12
#endif

namespace pg8 {
#define PG8_LAS __attribute__((address_space(3)))
typedef unsigned short bf16_t;
typedef short bf16x8 __attribute__((ext_vector_type(8)));
typedef float f32x4 __attribute__((ext_vector_type(4)));
typedef unsigned u32x4 __attribute__((ext_vector_type(4)));
constexpr int BM = 256, BK = 64, HALF = 128, HTB = HALF * BK * 2, STAGE_BYTES = 8 * HTB, NXCD = 8, WGM = 4;

__host__ __device__ __forceinline__ int lds_byte(int r, int c) { const int st = (r >> 4) * 2 + (c >> 5), rr = r & 15, cc = c & 31, ob = rr * 64 + cc * 2; return st * 1024 + (ob ^ (((ob >> 9) & 1) << 5)); }
__host__ __device__ __forceinline__ void stage_rc(int b, int& R, int& C) { const int st = b / 1024, sb = b % 1024, swz = sb ^ (((sb >> 9) & 1) << 5); R = (st >> 1) * 16 + swz / 64; C = (st & 1) * 32 + (swz % 64) / 2; }
__host__ __device__ __forceinline__ int perm32(int rho) { const int n = rho >> 4, i = rho & 15; return 8 * (i >> 2) + 4 * n + (i & 3); }

struct Unit { const char* a; const char* b; const int* idx; int pm, pn, aux; };

__device__ __forceinline__ void tile_of(int wgid, int nM, int nN, int& pm, int& pn) {
    const int nwg = nM * nN; { const int q = nwg / NXCD, r = nwg % NXCD, xcd = wgid % NXCD, off = wgid / NXCD; wgid = (xcd < r ? xcd * (q + 1) : r * (q + 1) + (xcd - r) * q) + off; }
    const int nig = WGM * nN, gid = wgid / nig, fm = gid * WGM, gsz = (nM - fm) < WGM ? (nM - fm) : WGM;
    pm = fm + ((wgid % nig) % gsz); pn = (wgid % nig) / gsz;
}

__device__ __forceinline__ unsigned cvt_pk_bf16(float lo, float hi) { unsigned r; asm volatile("s_nop 1\n\tv_cvt_pk_bf16_f32 %0, %1, %2" : "=v"(r) : "v"(lo), "v"(hi)); return r; }
__device__ __forceinline__ float bf_lo(unsigned u) { return __uint_as_float(u << 16); }
__device__ __forceinline__ float bf_hi(unsigned u) { return __uint_as_float(u & 0xffff0000u); }

typedef int i32x4 __attribute__((ext_vector_type(4)));
typedef int i32x8 __attribute__((ext_vector_type(8)));
template <int MODE> struct AccT { typedef f32x4 type; };
template <> struct AccT<1> { typedef i32x4 type; };
template <class Epi, class Sched, bool ALIGN_EPI = false, bool SP2 = false, int MODE = 0, bool GATHER = false>
__device__ __forceinline__ void gemm_phase(PG8_LAS unsigned char* lds, const int PA, const int PB, const int nt, const Sched& S, const Epi& E, const int wid_in) {
    const int tid = threadIdx.x, wid = __builtin_amdgcn_readfirstlane(tid >> 6), lane = tid & 63, wr = wid >> 2, wc = wid & 3, fr = lane & 15, fq = lane >> 4;
    typedef typename AccT<MODE>::type acc_t;
    unsigned voffA[2], voffB[2];
#pragma unroll
    for (int i = 0; i < 2; ++i) { int R, C; stage_rc(tid * 16 + i * 8192, R, C); const int Rb = (R & ~31) + perm32(R & 31);
        voffA[i] = (unsigned)(R * PA + C * 2); voffB[i] = (unsigned)(Rb * PB + C * 2); }
    unsigned vgC[2][2], vgN[2][2]; int gR[2], gC2[2];
    if constexpr (GATHER) { static_assert(SP2, "GATHER is written for the SP2 loop");
#pragma unroll
        for (int i = 0; i < 2; ++i) { int R, C; stage_rc(tid * 16 + i * 8192, R, C); gR[i] = R; gC2[i] = C * 2; } }
    PG8_LAS unsigned char* idxbuf = lds + 131072 + 4096;
#define PG8_IDX_DMA(ptr, slot) do { if (wid == 0) __builtin_amdgcn_global_load_lds((const unsigned*)((const char*)(ptr) + lane * 16), (PG8_LAS unsigned*)(idxbuf + (slot) * 1024), 16, 0, 0); } while (0)
#define PG8_IDX_READ(dst, slot) do { _Pragma("unroll") for (int h_ = 0; h_ < 2; ++h_) _Pragma("unroll") for (int i_ = 0; i_ < 2; ++i_) \
        dst[h_][i_] = (unsigned)(*(const PG8_LAS int*)(idxbuf + (slot) * 1024 + (h_ * 128 + gR[i_]) * 4)) * (unsigned)PA + (unsigned)gC2[i_]; } while (0)
    const size_t kstep = (size_t)(BK * 2);
    const size_t hstepA = (size_t)HALF * PA, hstepB = (size_t)HALF * PB;
    const unsigned ldsw = (unsigned)wid * 1024u;
    const int aoff = lds_byte(wr * 64 + fr, fq * 8), boff = lds_byte(wc * 32 + fr, fq * 8);
#define PG8_SA(b, h) (((b) * 2 + (h)) * HTB)
#define PG8_SB(b, h) ((4 + (b) * 2 + (h)) * HTB)
#define PG8_STAGE(bufoff, gbase, voff) do { _Pragma("unroll") for (int _i = 0; _i < 2; ++_i) \
        __builtin_amdgcn_global_load_lds((const unsigned*)((const char*)(gbase) + (voff)[_i]), (PG8_LAS unsigned*)(lds + (bufoff) + ldsw + _i * 8192), 16, 0, 0); } while (0)
#define PG8_STAGE_A(b, h, kptr, NXT) do { if constexpr (GATHER) { _Pragma("unroll") for (int _i = 0; _i < 2; ++_i) { const unsigned vo_ = (NXT) ? vgN[h][_i] : vgC[h][_i]; \
        __builtin_amdgcn_global_load_lds((const unsigned*)((const char*)(kptr) + vo_), (PG8_LAS unsigned*)(lds + PG8_SA(b, h) + ldsw + _i * 8192), 16, 0, 0); } } \
        else PG8_STAGE(PG8_SA(b, h), (kptr) + (h) * hstepA, voffA); } while (0)
#define PG8_LDA(dst, b, h) do { _Pragma("unroll") for (int m = 0; m < 4; ++m) { if constexpr (MODE == 2) { const i32x4 lo_ = *(const PG8_LAS i32x4*)(lds + PG8_SA(b, h) + aoff + m * 2048), hi_ = *(const PG8_LAS i32x4*)(lds + PG8_SA(b, h) + aoff + m * 2048 + 1024); \
            dst##8[m] = __builtin_shufflevector(lo_, hi_, 0, 1, 2, 3, 4, 5, 6, 7); } else { _Pragma("unroll") for (int k = 0; k < 2; ++k) dst[m][k] = *(const PG8_LAS bf16x8*)(lds + PG8_SA(b, h) + aoff + m * 2048 + k * 1024); } } } while (0)
#define PG8_LDB(dst, b, h) do { _Pragma("unroll") for (int n = 0; n < 2; ++n) { if constexpr (MODE == 2) { const i32x4 lo_ = *(const PG8_LAS i32x4*)(lds + PG8_SB(b, h) + boff + n * 2048), hi_ = *(const PG8_LAS i32x4*)(lds + PG8_SB(b, h) + boff + n * 2048 + 1024); \
            dst##8[n] = __builtin_shufflevector(lo_, hi_, 0, 1, 2, 3, 4, 5, 6, 7); } else { _Pragma("unroll") for (int k = 0; k < 2; ++k) dst[n][k] = *(const PG8_LAS bf16x8*)(lds + PG8_SB(b, h) + boff + n * 2048 + k * 1024); } } } while (0)
#define PG8_MMA(ai, bj, At, Bt) do { __builtin_amdgcn_s_setprio(1); _Pragma("unroll") for (int m = 0; m < 4; ++m) _Pragma("unroll") for (int n = 0; n < 2; ++n) { \
        if constexpr (MODE == 2) { asm volatile("v_mfma_scale_f32_16x16x128_f8f6f4 %0, %1, %2, %0, %3, %3 op_sel_hi:[0,0,0]" : "+v"(acc[ai][bj][m][n]) : "v"(Bt##8[n]), "v"(At##8[m]), "v"(sc127)); } \
        else { _Pragma("unroll") for (int k = 0; k < 2; ++k) { \
          if constexpr (MODE == 1) acc[ai][bj][m][n] = __builtin_amdgcn_mfma_i32_16x16x64_i8(__builtin_bit_cast(i32x4, Bt[n][k]), __builtin_bit_cast(i32x4, At[m][k]), acc[ai][bj][m][n], 0, 0, 0); \
          else acc[ai][bj][m][n] = __builtin_amdgcn_mfma_f32_16x16x32_bf16(Bt[n][k], At[m][k], acc[ai][bj][m][n], 0, 0, 0); } } } __builtin_amdgcn_s_setprio(0); } while (0)
#define PG8_WAIT_V(n) asm volatile("s_waitcnt vmcnt(" #n ")" ::: "memory")
#define PG8_WAIT_L(n) asm volatile("s_waitcnt lgkmcnt(" #n ")" ::: "memory")
#define PG8_BAR __builtin_amdgcn_s_barrier()
#define PG8_SCHED __builtin_amdgcn_sched_barrier(0)
    Unit cur, nxt; int ui = 0;
    if (!S.next(0, cur)) return;
    acc_t acc[2][2][4][2];
#pragma unroll
    for (int a = 0; a < 2; ++a)
#pragma unroll
        for (int b = 0; b < 2; ++b)
#pragma unroll
            for (int m = 0; m < 4; ++m)
#pragma unroll
                for (int n = 0; n < 2; ++n) acc[a][b][m][n] = (acc_t){0, 0, 0, 0};
    const int sc127 = 0x7F7F7F7F;
    bf16x8 At[4][2], B0[2][2], B1[2][2]; i32x8 At8[4], B08[2], B18[2];
    const char* cA = cur.a; const char* cB = cur.b;
    if constexpr (SP2) {
        if constexpr (GATHER) { PG8_IDX_DMA(cur.idx, 0); PG8_WAIT_V(0); __syncthreads(); PG8_IDX_READ(vgC, 0); PG8_WAIT_L(0);
#pragma unroll
            for (int h_ = 0; h_ < 2; ++h_) { vgN[h_][0] = vgC[h_][0]; vgN[h_][1] = vgC[h_][1]; } }
        PG8_STAGE(PG8_SB(0, 0), cB, voffB); PG8_STAGE(PG8_SB(0, 1), cB + hstepB, voffB); PG8_STAGE_A(0, 0, cA, false); PG8_STAGE_A(0, 1, cA, false);
        if (wr == 1) PG8_BAR;
        PG8_WAIT_V(2); PG8_BAR;
        PG8_STAGE(PG8_SB(1, 0), cB + kstep, voffB); PG8_STAGE_A(1, 0, cA + kstep, false); PG8_STAGE(PG8_SB(1, 1), cB + hstepB + kstep, voffB);
        PG8_WAIT_V(6); PG8_BAR;
    } else {
        PG8_STAGE(PG8_SB(0, 0), cB, voffB); PG8_STAGE(PG8_SA(0, 0), cA, voffA); PG8_STAGE(PG8_SB(0, 1), cB + hstepB, voffB); PG8_STAGE(PG8_SA(0, 1), cA + hstepA, voffA);
        if (wr == 1) PG8_BAR;
        PG8_WAIT_V(4); PG8_BAR;
        PG8_STAGE(PG8_SB(1, 0), cB + kstep, voffB); PG8_STAGE(PG8_SA(1, 0), cA + kstep, voffA); PG8_STAGE(PG8_SB(1, 1), cB + hstepB + kstep, voffB);
        PG8_WAIT_V(6); PG8_BAR;
    }
    for (;;) {
        const bool has_next = S.next(ui + 1, nxt);
        const char* nA = has_next ? nxt.a : cA; const char* nB = has_next ? nxt.b : cB;
        if constexpr (GATHER) { if (has_next) PG8_IDX_DMA(nxt.idx, (ui + 1) & 1); }
        for (int t = 0; t < nt; t += 2) {
            const bool last = (t == nt - 2);
            const char* a1 = cA + (size_t)(t + 1) * kstep;
            const char* a2 = last ? nA : cA + (size_t)(t + 2) * kstep; const char* b2 = last ? nB : cB + (size_t)(t + 2) * kstep;
            const char* a3 = a2 + kstep; const char* b3 = b2 + kstep;
            if constexpr (SP2) {
            if constexpr (GATHER) { if (t == 4 && has_next) PG8_IDX_READ(vgN, (ui + 1) & 1); }
            PG8_LDB(B0, 0, 0); PG8_LDB(B1, 0, 1); PG8_SCHED; PG8_LDA(At, 0, 0); PG8_STAGE_A(1, 1, a1, false);
            PG8_WAIT_V(8); PG8_WAIT_L(0); PG8_BAR; PG8_MMA(0, 0, At, B0); PG8_MMA(0, 1, At, B1); PG8_BAR; PG8_SCHED;
            PG8_LDA(At, 0, 1); PG8_STAGE(PG8_SB(0, 0), b2, voffB); PG8_STAGE(PG8_SB(0, 1), b2 + hstepB, voffB); PG8_STAGE_A(0, 0, a2, last);
            PG8_WAIT_V(8); PG8_WAIT_L(0); PG8_BAR; PG8_MMA(1, 0, At, B0); PG8_MMA(1, 1, At, B1); PG8_BAR; PG8_SCHED;
            PG8_LDB(B0, 1, 0); PG8_LDB(B1, 1, 1); PG8_SCHED; PG8_LDA(At, 1, 0); PG8_STAGE_A(0, 1, a2, last);
            PG8_WAIT_V(8); PG8_WAIT_L(0); PG8_BAR; PG8_MMA(0, 0, At, B0); PG8_MMA(0, 1, At, B1); PG8_BAR; PG8_SCHED;
            PG8_LDA(At, 1, 1); PG8_STAGE(PG8_SB(1, 0), b3, voffB); PG8_STAGE(PG8_SB(1, 1), b3 + hstepB, voffB); PG8_STAGE_A(1, 0, a3, last);
            PG8_WAIT_V(8); PG8_WAIT_L(0); PG8_BAR; PG8_MMA(1, 0, At, B0); PG8_MMA(1, 1, At, B1); PG8_BAR; PG8_SCHED;
            } else {
            PG8_LDB(B0, 0, 0); PG8_SCHED; PG8_LDA(At, 0, 0); PG8_STAGE(PG8_SA(1, 1), a1 + hstepA, voffA);
            PG8_WAIT_L(8); PG8_BAR; PG8_WAIT_L(0); PG8_MMA(0, 0, At, B0); PG8_BAR; PG8_SCHED;
            PG8_LDB(B1, 0, 1); PG8_STAGE(PG8_SB(0, 0), b2, voffB);
            PG8_BAR; PG8_WAIT_L(0); PG8_MMA(0, 1, At, B1); PG8_BAR;
            PG8_LDA(At, 0, 1); PG8_STAGE(PG8_SA(0, 0), a2, voffA);
            PG8_BAR; PG8_WAIT_L(0); PG8_MMA(1, 0, At, B0); PG8_BAR; PG8_SCHED;
            PG8_STAGE(PG8_SB(0, 1), b2 + hstepB, voffB);
            PG8_WAIT_V(6); PG8_BAR; PG8_MMA(1, 1, At, B1); PG8_BAR;
            PG8_LDB(B0, 1, 0); PG8_SCHED; PG8_LDA(At, 1, 0); PG8_STAGE(PG8_SA(0, 1), a2 + hstepA, voffA);
            PG8_WAIT_L(8); PG8_BAR; PG8_WAIT_L(0); PG8_MMA(0, 0, At, B0); PG8_BAR; PG8_SCHED;
            PG8_LDB(B1, 1, 1); PG8_STAGE(PG8_SB(1, 0), b3, voffB);
            PG8_BAR; PG8_WAIT_L(0); PG8_MMA(0, 1, At, B1); PG8_BAR;
            PG8_LDA(At, 1, 1); PG8_STAGE(PG8_SA(1, 0), a3, voffA);
            PG8_BAR; PG8_WAIT_L(0); PG8_MMA(1, 0, At, B0); PG8_BAR; PG8_SCHED;
            PG8_STAGE(PG8_SB(1, 1), b3 + hstepB, voffB);
            PG8_WAIT_V(6); PG8_BAR; PG8_MMA(1, 1, At, B1); PG8_BAR;
            }
        }
        if constexpr (ALIGN_EPI) { if (wr == 0) PG8_BAR; }
        E(acc, cur, wr, wc, fr, fq);
        if (!has_next) break;
#pragma unroll
        for (int a = 0; a < 2; ++a)
#pragma unroll
            for (int b = 0; b < 2; ++b)
#pragma unroll
                for (int m = 0; m < 4; ++m)
#pragma unroll
                    for (int n = 0; n < 2; ++n) acc[a][b][m][n] = (acc_t){0, 0, 0, 0};
        cur = nxt; cA = nA; cB = nB; ++ui;
        if constexpr (GATHER) {
#pragma unroll
            for (int h_ = 0; h_ < 2; ++h_) { vgC[h_][0] = vgN[h_][0]; vgC[h_][1] = vgN[h_][1]; } }
        if constexpr (ALIGN_EPI) { if (wr == 1) PG8_BAR; }
    }
    PG8_WAIT_V(0);
    if constexpr (!ALIGN_EPI) { if (wr == 0) PG8_BAR; }
    PG8_BAR;
#undef PG8_SA
#undef PG8_SB
#undef PG8_STAGE
#undef PG8_STAGE_A
#undef PG8_IDX_DMA
#undef PG8_IDX_READ
#undef PG8_LDA
#undef PG8_LDB
#undef PG8_MMA
#undef PG8_WAIT_V
#undef PG8_WAIT_L
#undef PG8_BAR
#undef PG8_SCHED
}
}

constexpr int D = 2048, TP = 16384, TS = 32768, M = TP + TS, NSEQ = 6;
constexpr int IN_W = 11264, KVW = 512, NE = 16, FF = 2816, CAP_P = TP / 8, CAP_S = TS / 8, NSLOT = NE * (CAP_P + CAP_S);
constexpr int MODW = 6 * D, ADA_KC = 8;
constexpr float NORM_EPS = 1e-6f;
constexpr int NWAVES = 8, NPHASE = 12;

constexpr size_t MiB = 1u << 20;
constexpr size_t WS_CTL = 0, CTL_ZERO_BYTES = 1 * MiB;
constexpr size_t WS_MODP = 1 * MiB;
constexpr size_t WS_MOD = 3 * MiB + 512 * 1024;
constexpr size_t WS_WIN = 4 * MiB;
constexpr size_t WS_WOA = 48 * MiB, WS_WOS = 56 * MiB, WS_WOUT = 64 * MiB;
constexpr size_t WS_WGU = 72 * MiB;
constexpr size_t WS_WD = 424 * MiB;
constexpr size_t WS_AFF = 600 * MiB;
constexpr size_t WS_AFFT = 603 * MiB;
constexpr size_t WS_INV = 606 * MiB;
constexpr size_t WS_SELI = 609 * MiB;
constexpr size_t WS_SELW = 609 * MiB + 512 * 1024;
constexpr size_t WS_U_FWD = 612 * MiB;
constexpr size_t WS_SGW = 610 * MiB;
constexpr size_t WS_SGU = 610 * MiB + 512 * 1024;
constexpr size_t WS_HS = 611 * MiB;
constexpr size_t WS_XS = 611 * MiB + 256 * 1024;
constexpr size_t WS_WDT = WS_U_FWD + 352 * MiB;
constexpr size_t WS_EMAX = 64 * 1024;
constexpr size_t WS_WSC = 611 * MiB + 640 * 1024;
constexpr size_t WS_H1Q = WS_WGU + 176 * MiB;
constexpr size_t WS_WIN8 = WS_WGU + 272 * MiB;
constexpr size_t WS_ATT8 = WS_H1Q;
constexpr size_t WS_WOA8 = WS_WIN8 + 24 * MiB;
constexpr size_t WS_OMAX = 64 * 1024 + 256;
constexpr size_t WS_WSCO = 610 * MiB + 960 * 1024;
constexpr size_t WS_MQ = WS_H1Q;
constexpr size_t WS_MS = WS_XS;
constexpr size_t WS_SWO = 610 * MiB + 976 * 1024;
constexpr size_t WS_HS1 = WS_XS;
constexpr size_t WS_SWIN = 610 * MiB + 896 * 1024;
constexpr size_t WS_CMAXIN = 512 * 1024 + 64 * 1024;
constexpr size_t WS_CMAX = 128 * 1024;
constexpr int NGUROWS = NE * 22 * 256;
constexpr size_t WS_U = 612 * MiB, WS_VG = 804 * MiB, WS_Q = 996 * MiB, WS_GA = 1188 * MiB, WS_GS = 1380 * MiB, WS_END = 1572 * MiB;
constexpr size_t WS_XE = WS_Q;
constexpr size_t WS_GUT = WS_U;
constexpr size_t WS_ACT = WS_U;
constexpr size_t DO_H1 = 0, DO_K = 192 * MiB, DO_V = 240 * MiB, DO_VST = 288 * MiB;
constexpr int CW_TMO = 0, CW_BAR = 4096;

constexpr int RING_OFF = 0, RING_BYTES = 131072, AUX_OFF = 131072, AUX_BYTES = 16384, MISC_OFF = AUX_OFF + AUX_BYTES, LDS_BYTES = MISC_OFF + 256;

#define GAS __attribute__((address_space(1)))
#define LAS __attribute__((address_space(3)))
typedef unsigned short bf16;
typedef unsigned v4u __attribute__((ext_vector_type(4)));
typedef unsigned v2u __attribute__((ext_vector_type(2)));
typedef float f32x4 __attribute__((ext_vector_type(4)));
typedef GAS unsigned gu32;
#define RLX_AGENT __ATOMIC_RELAXED, __HIP_MEMORY_SCOPE_AGENT
#define LDS_WAIT() asm volatile("s_waitcnt lgkmcnt(0)" ::: "memory")
#define VM_WAIT() asm volatile("s_waitcnt vmcnt(0)" ::: "memory")
using pg8::cvt_pk_bf16; using pg8::bf_lo; using pg8::bf_hi;

#define XB_TMO      128
#define XB_XCNT(j)  (256  + 64 * (j))
#define XB_XSUB(j)  (1280 + 64 * (j))
#define XB_XGEN(j)  (2304 + 64 * (j))
#define XB_TOP      3328
#define XB_TOPGEN   3392
#define XCD_BAR_WORDS 3456
#define XB_SPIN_CAP (1u << 22)
__device__ __forceinline__ unsigned xb_ld(unsigned* p)              { return __hip_atomic_load(p, __ATOMIC_RELAXED, __HIP_MEMORY_SCOPE_AGENT); }
__device__ __forceinline__ unsigned xb_add(unsigned* p, unsigned v) { return __hip_atomic_fetch_add(p, v, __ATOMIC_RELAXED, __HIP_MEMORY_SCOPE_AGENT); }
__device__ __forceinline__ unsigned xb_xcc_id() { return (unsigned)__builtin_amdgcn_s_getreg((3 << 11) | 20) & 0xFu; }
#define XB_SPIN(cond, bar) do { unsigned _sp = 0; while (cond) { __builtin_amdgcn_s_sleep(1); \
    if ((++_sp & 255u) == 0u) { if (xb_ld(&(bar)[XB_TMO])) break; if (_sp > XB_SPIN_CAP) { atomicAdd(&(bar)[XB_TMO], 1u); break; } } } } while (0)
struct XcdBarrier { unsigned* bar; unsigned x; volatile LAS unsigned* st; int wave; };
__device__ __forceinline__ XcdBarrier xcd_barrier_post(unsigned* bar, volatile LAS unsigned* st) {
    XcdBarrier b; b.bar = bar; b.x = xb_xcc_id(); b.st = st; b.wave = __builtin_amdgcn_readfirstlane((int)threadIdx.x >> 6);
    if (threadIdx.x == 0) (void)xb_add(&bar[XB_XCNT(b.x)], 1u);
    return b;
}
__device__ __forceinline__ void xcd_barrier_complete(unsigned* bar, unsigned x, unsigned& nloc, unsigned& nx) {
    const unsigned G = gridDim.x * gridDim.y * gridDim.z;
    unsigned sum, cnt, mine, sp = 0u;
    for (;;) {
        sum = 0u; cnt = 0u; mine = 0u;
#pragma unroll
        for (unsigned j = 0; j < 16; ++j) { const unsigned c = xb_ld(&bar[XB_XCNT(j)]); sum += c; cnt += (c > 0u) ? 1u : 0u; mine = (j == x) ? c : mine; }
        if (sum == G) break;
        __builtin_amdgcn_s_sleep(1);
        if ((++sp & 255u) == 0u) { if (xb_ld(&bar[XB_TMO])) break; if (sp > XB_SPIN_CAP) { atomicAdd(&bar[XB_TMO], 1u); break; } }
    }
    nloc = mine > 0u ? mine : 1u; nx = cnt > 0u ? cnt : 1u;
}
__device__ __forceinline__ void xcd_barrier(const XcdBarrier& b) {
    asm volatile("s_waitcnt vmcnt(0)" ::: "memory");
    __syncthreads();
    int l0_; asm volatile("v_mbcnt_lo_u32_b32 %0, -1, 0\n\tv_mbcnt_hi_u32_b32 %0, -1, %0" : "=v"(l0_));
    if (b.wave == 0 && l0_ == 0) {
        unsigned* bar = b.bar;
        __builtin_amdgcn_s_waitcnt(0);
        unsigned nloc = b.st[0], nx = b.st[1];
        if (nloc == 0u) { xcd_barrier_complete(bar, b.x, nloc, nx); b.st[0] = nloc; b.st[1] = nx; }
        const unsigned old = xb_add(&bar[XB_XSUB(b.x)], 1u);
        const unsigned gen = old / nloc;
        if (old + 1u == (gen + 1u) * nloc) {
            __builtin_amdgcn_fence(__ATOMIC_RELEASE, "agent");
            asm volatile("s_waitcnt vmcnt(0)" ::: "memory");
            const unsigned og = xb_add(&bar[XB_TOP], 1u);
            const unsigned tg = og / nx;
            if (og + 1u == (tg + 1u) * nx) xb_add(&bar[XB_TOPGEN], 1u);
            else XB_SPIN(xb_ld(&bar[XB_TOPGEN]) == tg, bar);
            __builtin_amdgcn_fence(__ATOMIC_ACQUIRE, "agent");
            xb_add(&bar[XB_XGEN(b.x)], 1u);
            asm volatile("s_waitcnt vmcnt(0)" ::: "memory");
        } else {
            XB_SPIN(xb_ld(&bar[XB_XGEN(b.x)]) == gen, bar);
            __builtin_amdgcn_fence(__ATOMIC_ACQUIRE, "agent");
            asm volatile("s_waitcnt vmcnt(0)" ::: "memory");
        }
    }
    __syncthreads();
}

struct Args { const float* in[23]; float* out; unsigned char* ws; int ph_lo, ph_hi, li, pad; };
struct Frame {
    LAS unsigned char* lds;
    int tid, lane, wave, vcu, G;
    const float* const* in;
    float* out; unsigned char* ws;
};
__device__ __forceinline__ int fresh_lane() { int l; asm volatile("v_mbcnt_lo_u32_b32 %0, -1, 0\n\tv_mbcnt_hi_u32_b32 %0, -1, %0" : "=v"(l)); return l; }
template <int CTRL> __device__ __forceinline__ float dpp_mov(float v) { return __int_as_float(__builtin_amdgcn_update_dpp(0, __float_as_int(v), CTRL, 0xF, 0xF, true)); }
__device__ __forceinline__ float lane_bcast(float v, int l) { return __int_as_float(__builtin_amdgcn_readlane(__float_as_int(v), l)); }
__device__ __forceinline__ float wave_sum(float v) {
    v += dpp_mov<0xB1>(v); v += dpp_mov<0x4E>(v); v += dpp_mov<0x141>(v); v += dpp_mov<0x140>(v);
    return (lane_bcast(v, 0) + lane_bcast(v, 16)) + (lane_bcast(v, 32) + lane_bcast(v, 48));
}
__device__ __forceinline__ int wave_sum_i(int v) {
    v += __builtin_amdgcn_update_dpp(0, v, 0xB1, 0xF, 0xF, true); v += __builtin_amdgcn_update_dpp(0, v, 0x4E, 0xF, 0xF, true); v += __builtin_amdgcn_update_dpp(0, v, 0x141, 0xF, 0xF, true); v += __builtin_amdgcn_update_dpp(0, v, 0x140, 0xF, 0xF, true);
    return (__builtin_amdgcn_readlane(v, 0) + __builtin_amdgcn_readlane(v, 16)) + (__builtin_amdgcn_readlane(v, 32) + __builtin_amdgcn_readlane(v, 48));
}
__device__ __forceinline__ float wave_max(float v) {
    v = fmaxf(v, dpp_mov<0xB1>(v)); v = fmaxf(v, dpp_mov<0x4E>(v)); v = fmaxf(v, dpp_mov<0x141>(v)); v = fmaxf(v, dpp_mov<0x140>(v));
    return fmaxf(fmaxf(lane_bcast(v, 0), lane_bcast(v, 16)), fmaxf(lane_bcast(v, 32), lane_bcast(v, 48)));
}
__device__ __forceinline__ int seq_of(int m) { return m < TP ? (m >> 12) : 4 + ((m - TP) >> 14); }
__device__ __forceinline__ int seq_start(int s) { return s < 4 ? s * 4096 : TP + (s - 4) * 16384; }
__device__ __forceinline__ int seq_len(int s) { return s < 4 ? 4096 : 16384; }
__device__ __forceinline__ const float* xrow_ptr(const Frame& F, int m) { return m < TP ? F.in[0] + (size_t)m * D : F.in[1] + (size_t)(m - TP) * D; }

__device__ __forceinline__ void ada_item(const Frame& F, int it, LAS float* scr) {
    const int kc = it / 48, jc = it % 48, lane = F.lane;
#pragma unroll
    for (int s = 0; s < NSEQ; ++s) { const float* cp = s < 4 ? F.in[2] + s * D : F.in[3] + (s - 4) * D;
#pragma unroll
        for (int i = 0; i < 4; ++i) { const float v = cp[kc * 256 + lane + 64 * i]; scr[s * 256 + lane + 64 * i] = v / (1.0f + __expf(-v)); } }
    LDS_WAIT(); asm volatile("" ::: "memory");
    f32x4 acc[NSEQ];
#pragma unroll
    for (int s = 0; s < NSEQ; ++s) acc[s] = (f32x4){0.f, 0.f, 0.f, 0.f};
    const float* wp = F.in[4] + (size_t)(kc * 256) * MODW + jc * 256 + 4 * lane;
#pragma unroll 8
    for (int k = 0; k < 256; ++k) { const f32x4 w = *(const f32x4*)(wp + (size_t)k * MODW);
#pragma unroll
        for (int s = 0; s < NSEQ; ++s) acc[s] += w * scr[s * 256 + k]; }
    float* modp = (float*)(F.ws + WS_MODP);
#pragma unroll
    for (int s = 0; s < NSEQ; ++s) *(f32x4*)(modp + (size_t)(kc * NSEQ + s) * MODW + jc * 256 + 4 * lane) = acc[s];
    LDS_WAIT(); asm volatile("" ::: "memory");
}
__device__ __forceinline__ int q8(float v) { return (int)rintf(fminf(fmaxf(v, -127.0f), 127.0f)); }
__device__ __forceinline__ unsigned q8x4(float a, float b, float c, float d, float inv) {
    typedef float f2_t __attribute__((ext_vector_type(2))); const f2_t mm = {inv, inv}, mg = {12582912.0f, 12582912.0f};
    const f2_t y0 = __builtin_elementwise_fma((f2_t){a, b}, mm, mg), y1 = __builtin_elementwise_fma((f2_t){c, d}, mm, mg);
    return __builtin_amdgcn_perm(__builtin_amdgcn_perm(__float_as_uint(y1.y), __float_as_uint(y1.x), 0x0c0c0400u), __builtin_amdgcn_perm(__float_as_uint(y0.y), __float_as_uint(y0.x), 0x0c0c0400u), 0x05040100u);
}
template <int NC, int FMT  , int K> __device__ __forceinline__ void strip_item(const Frame& F, const float* W, int ldw, unsigned char* dst, size_t dst_pitch, float* scale_out) {
    constexpr int CGS = NC / 4, RPW = 64 / CGS;
    const int lane = F.lane, w = F.wave, cg = lane % CGS, rp = lane / CGS;
    LAS unsigned* strip = (LAS unsigned*)(F.lds + RING_OFF); LAS float* cmx = (LAS float*)(F.lds + AUX_OFF + 2048);
    constexpr int PITCH = K / 2; const int swA = (NC == 32 ? 4 : 8) * cg;
    float mx[4] = {0.f, 0.f, 0.f, 0.f};
    constexpr int rows_per_step = NWAVES * 2 * RPW, nsteps = K / rows_per_step;
    const float* wp = W + (size_t)(w * 2 * RPW + 2 * rp) * ldw + 4 * cg;
    f32x4 ra0[4], rb0[4], ra1[4], rb1[4];
#define ST_LOAD(ra, rb, s0) do { _Pragma("unroll") for (int u = 0; u < 4; ++u) if ((s0) + u < nsteps) { const float* q = wp + (size_t)((s0) + u) * rows_per_step * ldw; ra[u] = *(const f32x4*)q; rb[u] = *(const f32x4*)(q + ldw); } } while (0)
#define ST_PROC(ra, rb, s0) do { _Pragma("unroll") for (int u = 0; u < 4; ++u) if ((s0) + u < nsteps) { const int kp = (((s0) + u) * rows_per_step) / 2 + w * RPW + rp; \
        _Pragma("unroll") for (int c = 0; c < 4; ++c) { mx[c] = fmaxf(mx[c], fmaxf(fabsf(ra[u][c]), fabsf(rb[u][c]))); strip[(4 * cg + c) * PITCH + (kp ^ swA)] = cvt_pk_bf16(ra[u][c], rb[u][c]); } } } while (0)
    ST_LOAD(ra0, rb0, 0);
#pragma unroll
    for (int st = 0; st < nsteps; st += 8) {
        if (st + 4 < nsteps) ST_LOAD(ra1, rb1, st + 4);
        ST_PROC(ra0, rb0, st);
        if (st + 8 < nsteps) ST_LOAD(ra0, rb0, st + 8);
        if (st + 4 < nsteps) ST_PROC(ra1, rb1, st + 4);
    }
#undef ST_LOAD
#undef ST_PROC
#pragma unroll
    for (int c = 0; c < 4; ++c) { float m = mx[c];
#pragma unroll
        for (int o = CGS; o < 64; o <<= 1) m = fmaxf(m, __shfl_xor(m, o));
        if (rp == 0) cmx[w * NC + 4 * cg + c] = m; }
    __syncthreads();
    constexpr int CPW = NC / NWAVES;
    constexpr int nchunk = K / 8;
#pragma unroll
    for (int ci = 0; ci < CPW; ++ci) { const int n = w * CPW + ci; float amax = 0.f;
#pragma unroll
        for (int ww = 0; ww < NWAVES; ++ww) amax = fmaxf(amax, cmx[ww * NC + n]);
        const int swq = (NC == 32 ? 1 : 2) * ((n >> 2) % CGS);
        float mul, deq;
        if (FMT == 1) { mul = amax > 0.f ? 127.0f / amax : 0.f; deq = amax * (1.0f / 127.0f); }
        else if (FMT == 2) { const int sft = amax > 0.f ? (int)floorf(log2f(448.0f / amax)) : 0; mul = exp2f((float)sft); deq = exp2f(-(float)sft); }
        else { mul = 1.f; deq = 1.f; }
        const LAS unsigned char* rowp = (const LAS unsigned char*)(strip + n * PITCH); unsigned char* drow = dst + (size_t)n * dst_pitch;
        for (int pc = lane; pc < nchunk; pc += 64) { const v4u x = *(const LAS v4u*)(rowp + pc * 16); const int q = pc ^ swq;
            if (FMT == 0) *(v4u*)(drow + q * 16) = x;
            else if (FMT == 1) { v2u o; o.x = q8x4(bf_lo(x.x), bf_hi(x.x), bf_lo(x.y), bf_hi(x.y), mul); o.y = q8x4(bf_lo(x.z), bf_hi(x.z), bf_lo(x.w), bf_hi(x.w), mul); *(v2u*)(drow + q * 8) = o; }
            else { v2u o; unsigned t = 0u; t = __builtin_amdgcn_cvt_pk_fp8_f32(bf_lo(x.x) * mul, bf_hi(x.x) * mul, t, false); t = __builtin_amdgcn_cvt_pk_fp8_f32(bf_lo(x.y) * mul, bf_hi(x.y) * mul, t, true); o.x = t;
                t = __builtin_amdgcn_cvt_pk_fp8_f32(bf_lo(x.z) * mul, bf_hi(x.z) * mul, t, false); t = __builtin_amdgcn_cvt_pk_fp8_f32(bf_lo(x.w) * mul, bf_hi(x.w) * mul, t, true); o.y = t; *(v2u*)(drow + q * 8) = o; } }
        if (FMT != 0 && lane == 0) scale_out[n] = deq; }
    __syncthreads();
}
__device__ __forceinline__ void p0_prologue(const Frame& F) {
    { LAS float* scr = (LAS float*)(F.lds + RING_OFF + F.wave * 16384);
      const int gw = F.vcu * NWAVES + F.wave, NGW = F.G * NWAVES; constexpr int I_ADA = ADA_KC * 48, I_SGW = 64;
      for (int it = gw; it < I_ADA + I_SGW; it += NGW) {
          if (it < I_ADA) { ada_item(F, it, scr); continue; }
          const int r = it - I_ADA; const float* src = F.in[14] + (size_t)r * 4096; bf16* dst = (bf16*)(F.ws + WS_SGW) + (size_t)r * 4096;
#pragma unroll
          for (int q = 0; q < 8; ++q) { const f32x4 a = *(const f32x4*)(src + 8 * (F.lane + 64 * q)), b = *(const f32x4*)(src + 8 * (F.lane + 64 * q) + 4);
              v4u o; o.x = cvt_pk_bf16(a.x, a.y); o.y = cvt_pk_bf16(a.z, a.w); o.z = cvt_pk_bf16(b.x, b.y); o.w = cvt_pk_bf16(b.z, b.w); *(v4u*)(dst + 8 * (F.lane + 64 * q)) = o; } } }
    __syncthreads();
    constexpr int S_IN = IN_W / 32, S_O = D / 32, S_GU = NE * 2 * (FF / 32), S_DN = NE * (D / 16), NSTRIP = S_IN + 3 * S_O + S_GU + S_DN;
    unsigned char* const ws = F.ws;
    for (int it = F.vcu; it < NSTRIP; it += F.G) {
        int r = it;
        if (r < S_GU) { const int mat = r / (FF / 32), nb = r % (FF / 32), e = mat >> 1, up = mat & 1, n0 = 32 * nb;
            const size_t drow = (size_t)(e * 22 + n0 / 128) * 256 + up * 128 + (n0 % 128);
            strip_item<32, 1, D>(F, F.in[up ? 21 : 20] + (size_t)e * D * FF + n0, FF, ws + WS_WGU + drow * D, D, (float*)(ws + WS_SGU) + drow); continue; } r -= S_GU;
        if (r < S_DN) { const int e = r / (D / 16), n0 = 16 * (r % (D / 16));
            strip_item<16, 2, FF>(F, F.in[22] + (size_t)e * FF * D + n0, D, ws + WS_WD + ((size_t)e * D + n0) * FF, FF, (float*)(ws + WS_WSC) + e * D + n0); continue; } r -= S_DN;
        if (r < S_IN) { const int n0 = 32 * r; strip_item<32, 1, D>(F, F.in[8] + n0, IN_W, ws + WS_WIN8 + (size_t)n0 * D, D, (float*)(ws + WS_SWIN) + n0); continue; } r -= S_IN;
        { const int wsel = r / S_O, n0 = 32 * (r % S_O);
          if (wsel == 0) strip_item<32, 2, D>(F, F.in[16] + n0, D, ws + WS_WOA8 + (size_t)n0 * D, D, (float*)(ws + WS_WSCO) + n0);
          else if (wsel == 1) strip_item<32, 0, D>(F, F.in[17] + n0, D, ws + WS_WOS + (size_t)n0 * D * 2, D * 2, nullptr);
          else strip_item<32, 1, D>(F, F.in[18] + n0, D, ws + WS_WOUT + (size_t)n0 * D, D, (float*)(ws + WS_SWO) + n0); }
    }
}

template <int WHICH> __device__ __forceinline__ void load_modl(const Frame& F, int s, LAS float* modl) {
    const float* modp = (const float*)(F.ws + WS_MODP); const float* mod = (const float*)(F.ws + WS_MOD); const float* bada = F.in[5];
    for (int j = F.tid; j < 2 * D; j += NWAVES * 64) {
        float v;
        if (WHICH == 1) { const int col = j; v = bada[col];
#pragma unroll
            for (int kc = 0; kc < ADA_KC; ++kc) v += modp[(size_t)(kc * NSEQ + s) * MODW + col]; }
        else v = mod[(size_t)s * MODW + 3 * D + j];
        modl[j] = (j >= D) ? (1.0f + v) * F.in[WHICH == 1 ? 6 : 7][j - D] : v;
    }
}
__device__ __forceinline__ void p1_rows(const Frame& F) {
    LAS float* modl = (LAS float*)(F.lds + AUX_OFF);
    { const float* modp = (const float*)(F.ws + WS_MODP); float* mod = (float*)(F.ws + WS_MOD); const float* bada = F.in[5];
      for (int idx = F.vcu * 512 + F.tid; idx < NSEQ * MODW; idx += F.G * 512) { const int s = idx / MODW, j = idx % MODW; float v = bada[j];
#pragma unroll
          for (int kc = 0; kc < ADA_KC; ++kc) v += modp[(size_t)(kc * NSEQ + s) * MODW + j];
          mod[idx] = v; } }
    const int RPB = (M + F.G - 1) / F.G, r0 = F.vcu * RPB, r1 = (r0 + RPB < M) ? r0 + RPB : M;
    unsigned* h1q = (unsigned*)(F.ws + WS_H1Q); float* hs1 = (float*)(F.ws + WS_HS1);
    const float* g1n = F.in[6]; bf16* h1 = (DBG_NPH == 3) ? (bf16*)(F.ws + WS_WGU) : (bf16*)((unsigned char*)F.out + DO_H1);
    for (int row = r0; row < r1;) {
        const int s = seq_of(row); int end = seq_start(s) + seq_len(s); if (end > r1) end = r1;
        load_modl<1>(F, s, modl);
        __syncthreads();
        f32x4 vn[8];
        { const int mf = row + F.wave; if (mf < end) { const f32x4* xr = (const f32x4*)xrow_ptr(F, mf) + F.lane;
#pragma unroll
            for (int j = 0; j < 8; ++j) vn[j] = xr[64 * j]; } }
        for (int m = row + F.wave; m < end; m += NWAVES) {
            f32x4 v[8]; float ss = 0.f;
#pragma unroll
            for (int j = 0; j < 8; ++j) v[j] = vn[j];
            if (m + NWAVES < end) { const f32x4* xr = (const f32x4*)xrow_ptr(F, m + NWAVES) + F.lane;
#pragma unroll
                for (int j = 0; j < 8; ++j) vn[j] = xr[64 * j]; }
#pragma unroll
            for (int j = 0; j < 8; ++j) ss += (v[j].x * v[j].x + v[j].y * v[j].y) + (v[j].z * v[j].z + v[j].w * v[j].w);
            const float rstd = 1.0f / sqrtf(wave_sum(ss) * (1.0f / D) + NORM_EPS);
            float amax = 0.f;
#pragma unroll
            for (int j = 0; j < 8; ++j) { const int d = 4 * (F.lane + 64 * j);
                const f32x4 sh = *(const LAS f32x4*)(modl + d), sc = *(const LAS f32x4*)(modl + D + d);
                const f32x4 y = v[j] * rstd * sc + sh; v[j] = y; amax = fmaxf(fmaxf(amax, fmaxf(fabsf(y.x), fabsf(y.y))), fmaxf(fabsf(y.z), fabsf(y.w)));
                }
            amax = wave_max(amax);
            { const float inv = amax > 0.f ? 127.0f / amax : 0.f; unsigned* o4 = h1q + (size_t)m * (D / 4) + F.lane;
#pragma unroll
              for (int j = 0; j < 8; ++j) o4[64 * j] = q8x4(v[j].x, v[j].y, v[j].z, v[j].w, inv);
              if (F.lane == 0) hs1[m] = amax * (1.0f / 127.0f); }
        }
        __syncthreads();
        row = end;
    }
}
__device__ __forceinline__ void p6_rows(const Frame& F) {
    LAS float* modl = (LAS float*)(F.lds + AUX_OFF);
    LAS float* wrt = (LAS float*)(F.lds + RING_OFF);
    { const float* wr = F.in[19]; for (int idx = F.tid; idx < D * NE; idx += NWAVES * 64) wrt[(idx & 15) * D + (idx >> 4)] = wr[idx]; }
    const int RPB = (M + F.G - 1) / F.G, r0 = F.vcu * RPB, r1 = (r0 + RPB < M) ? r0 + RPB : M;
    const float* g2n = F.in[7]; unsigned* h2q = (unsigned*)(F.ws + WS_Q); float* hs = (float*)(F.ws + WS_HS);
    float* aff = (float*)(F.ws + WS_AFF); float* affT = (float*)(F.ws + WS_AFFT);
    for (int row = r0; row < r1;) {
        const int s = seq_of(row); int end = seq_start(s) + seq_len(s); if (end > r1) end = r1;
        load_modl<2>(F, s, modl);
        __syncthreads();
        f32x4 vn0[8], vn1[8];
        { const int mf = row + 2 * F.wave; if (mf < end) { const int mf1 = mf + 1 < end ? mf + 1 : mf; const f32x4* x0 = (const f32x4*)(F.out + (size_t)mf * D) + F.lane; const f32x4* x1 = (const f32x4*)(F.out + (size_t)mf1 * D) + F.lane;
#pragma unroll
            for (int j = 0; j < 8; ++j) { vn0[j] = x0[64 * j]; vn1[j] = x1[64 * j]; } } }
        for (int m = row + 2 * F.wave; m < end; m += 2 * NWAVES) {
            const bool two = m + 1 < end; const int m1 = two ? m + 1 : m;
            f32x4 v0[8], v1[8]; float ss0 = 0.f, ss1 = 0.f;
#pragma unroll
            for (int j = 0; j < 8; ++j) { v0[j] = vn0[j]; v1[j] = vn1[j]; }
            if (m + 2 * NWAVES < end) { const int mn = m + 2 * NWAVES, mn1 = mn + 1 < end ? mn + 1 : mn; const f32x4* x0 = (const f32x4*)(F.out + (size_t)mn * D) + F.lane; const f32x4* x1 = (const f32x4*)(F.out + (size_t)mn1 * D) + F.lane;
#pragma unroll
                for (int j = 0; j < 8; ++j) { vn0[j] = x0[64 * j]; vn1[j] = x1[64 * j]; } }
#pragma unroll
            for (int j = 0; j < 8; ++j) { ss0 += (v0[j].x * v0[j].x + v0[j].y * v0[j].y) + (v0[j].z * v0[j].z + v0[j].w * v0[j].w); ss1 += (v1[j].x * v1[j].x + v1[j].y * v1[j].y) + (v1[j].z * v1[j].z + v1[j].w * v1[j].w); }
            const float rstd0 = 1.0f / sqrtf(wave_sum(ss0) * (1.0f / D) + NORM_EPS), rstd1 = 1.0f / sqrtf(wave_sum(ss1) * (1.0f / D) + NORM_EPS);
            float amax0 = 0.f, amax1 = 0.f;
#pragma unroll
            for (int j = 0; j < 8; ++j) { const int d = 4 * (F.lane + 64 * j);
                const f32x4 sh = *(const LAS f32x4*)(modl + d), gs = *(const LAS f32x4*)(modl + D + d);
                const f32x4 y0 = v0[j] * rstd0 * gs + sh, y1 = v1[j] * rstd1 * gs + sh; v0[j] = y0; v1[j] = y1;
                amax0 = fmaxf(fmaxf(amax0, fmaxf(fabsf(y0.x), fabsf(y0.y))), fmaxf(fabsf(y0.z), fabsf(y0.w))); amax1 = fmaxf(fmaxf(amax1, fmaxf(fabsf(y1.x), fabsf(y1.y))), fmaxf(fabsf(y1.z), fabsf(y1.w))); }
            amax0 = wave_max(amax0); amax1 = wave_max(amax1);
            { const float inv = amax0 > 0.f ? 127.0f / amax0 : 0.f; unsigned* o4 = h2q + (size_t)m * (D / 4) + F.lane;
#pragma unroll
              for (int j = 0; j < 8; ++j) o4[64 * j] = q8x4(v0[j].x, v0[j].y, v0[j].z, v0[j].w, inv);
              if (F.lane == 0) hs[m] = amax0 * (1.0f / 127.0f); }
            if (two) { const float inv = amax1 > 0.f ? 127.0f / amax1 : 0.f; unsigned* o4 = h2q + (size_t)m1 * (D / 4) + F.lane;
#pragma unroll
              for (int j = 0; j < 8; ++j) o4[64 * j] = q8x4(v1[j].x, v1[j].y, v1[j].z, v1[j].w, inv);
              if (F.lane == 0) hs[m1] = amax1 * (1.0f / 127.0f); }
            asm volatile("" ::: "memory");
            float lg0[NE], lg1[NE];
#pragma unroll
            for (int e = 0; e < NE; ++e) { f32x4 a0 = {0.f, 0.f, 0.f, 0.f}, a1 = {0.f, 0.f, 0.f, 0.f};
#pragma unroll
                for (int j = 0; j < 8; ++j) { const f32x4 wv = *(const LAS f32x4*)(wrt + e * D + 4 * (F.lane + 64 * j)); a0 += v0[j] * wv; a1 += v1[j] * wv; }
                lg0[e] = (a0.x + a0.y) + (a0.z + a0.w); lg1[e] = (a1.x + a1.y) + (a1.z + a1.w); asm volatile("" ::: "memory"); }
            const int ln = F.lane;
#define P6_TREDUCE(lg, lgt) do { float r8[8], r4[4], r2[2]; \
            { const bool hb = (ln >> 5) & 1; _Pragma("unroll") for (int i = 0; i < 8; ++i) { const float keep = hb ? lg[8 + i] : lg[i], send = hb ? lg[i] : lg[8 + i]; r8[i] = keep + __shfl_xor(send, 32); } } \
            { const bool hb = (ln >> 4) & 1; _Pragma("unroll") for (int i = 0; i < 4; ++i) { const float keep = hb ? r8[4 + i] : r8[i], send = hb ? r8[i] : r8[4 + i]; r4[i] = keep + __shfl_xor(send, 16); } } \
            { const bool hb = (ln >> 3) & 1; _Pragma("unroll") for (int i = 0; i < 2; ++i) { const float keep = hb ? r4[2 + i] : r4[i], send = hb ? r4[i] : r4[2 + i]; r2[i] = keep + __shfl_xor(send, 8); } } \
            { const bool hb = (ln >> 2) & 1; const float keep = hb ? r2[1] : r2[0], send = hb ? r2[0] : r2[1]; lgt = keep + __shfl_xor(send, 4); } \
            lgt += __shfl_xor(lgt, 1); lgt += __shfl_xor(lgt, 2); } while (0)
#define P6_SOFTMAX_STORE(lgt, mrow) do { float mx = lgt; _Pragma("unroll") for (int o = 4; o < 64; o <<= 1) mx = fmaxf(mx, __shfl_xor(mx, o)); \
            const float ex = expf(lgt - mx); float den = ex; _Pragma("unroll") for (int o = 4; o < 64; o <<= 1) den += __shfl_xor(den, o); \
            const float mine = ex / den; const int e = ln >> 2; \
            if ((ln & 3) == 0) { aff[(size_t)(mrow) * NE + e] = mine; \
                if ((mrow) < TP) affT[(size_t)e * TP + (mrow)] = mine; else affT[(size_t)NE * TP + (size_t)e * TS + ((mrow) - TP)] = mine; } } while (0)
            float lgt0, lgt1; P6_TREDUCE(lg0, lgt0); P6_TREDUCE(lg1, lgt1);
            P6_SOFTMAX_STORE(lgt0, m);
            if (two) P6_SOFTMAX_STORE(lgt1, m1);
#undef P6_TREDUCE
#undef P6_SOFTMAX_STORE
        }
        __syncthreads();
        row = end;
    }
}

using pg8::Unit; using pg8::bf16_t;
__device__ __forceinline__ float gelu_tanh(float x) { const float t = x * (1.0f + 0.044715f * x * x) * (-2.0f * 0.7978845608028654f * 1.4426950408889634f); return x * __builtin_amdgcn_rcpf(1.0f + __builtin_amdgcn_exp2f(t)); }
__device__ __forceinline__ float sigmoid_f(float x) { return __builtin_amdgcn_rcpf(1.0f + __builtin_amdgcn_exp2f(-1.4426950408889634f * x)); }
template <int ACT> __device__ __forceinline__ float act_f(float x) { return ACT == 1 ? gelu_tanh(x) : (ACT == 2 || ACT == 3) ? sigmoid_f(x) : x; }
template <int ACT> __device__ __forceinline__ void store_tile_bf16(const f32x4 (&acc)[2][2][4][2], bf16_t* base, int ldc, int row0, int col0) {
#pragma unroll
    for (int ai = 0; ai < 2; ++ai)
#pragma unroll
        for (int m = 0; m < 4; ++m) { bf16_t* rowp = base + (size_t)(row0 + ai * 128 + m * 16) * ldc + col0;
#pragma unroll
            for (int bj = 0; bj < 2; ++bj) { const f32x4 v0 = acc[ai][bj][m][0], v1 = acc[ai][bj][m][1]; v4u w;
                w.x = cvt_pk_bf16(act_f<ACT>(v0[0]), act_f<ACT>(v0[1])); w.y = cvt_pk_bf16(act_f<ACT>(v0[2]), act_f<ACT>(v0[3]));
                w.z = cvt_pk_bf16(act_f<ACT>(v1[0]), act_f<ACT>(v1[1])); w.w = cvt_pk_bf16(act_f<ACT>(v1[2]), act_f<ACT>(v1[3]));
                *(v4u*)(rowp + bj * 128) = w; } }
}
struct EpiIn {
    bf16_t *Q, *Kb, *Vb, *U, *VG, *GA, *GS; float* VST;
    __device__ __forceinline__ void operator()(const f32x4 (&acc)[2][2][4][2], const Unit& u, int wr, int wc, int fr, int fq) const {
        const int pn = u.pn; bf16_t* base; int ldc, colt, act;
        if (pn < 8) { base = Q; ldc = D; colt = pn * 256; act = 0; }
        else if (pn < 10) { base = Kb; ldc = KVW; colt = (pn - 8) * 256; act = 0; }
        else if (pn < 12) { base = Vb; ldc = KVW; colt = (pn - 10) * 256; act = 0; }
        else if (pn < 20) { base = U; ldc = D; colt = (pn - 12) * 256; act = 1; }
        else if (pn < 28) { base = VG; ldc = D; colt = (pn - 20) * 256; act = 1; }
        else if (pn < 36) { base = GA; ldc = D; colt = (pn - 28) * 256; act = 2; }
        else { base = GS; ldc = D; colt = (pn - 36) * 256; act = 2; }
        const int row0 = u.pm * 256 + wr * 64 + fr, col0 = colt + wc * 32 + 8 * fq;
        if (act == 0) store_tile_bf16<0>(acc, base, ldc, row0, col0);
        else if (act == 2) store_tile_bf16<2>(acc, base, ldc, row0, col0);
        else if (pn < 20) store_tile_bf16<1>(acc, base, ldc, row0, col0);
        else {
            const int fq_ = fq;
#pragma unroll
            for (int ai = 0; ai < 2; ++ai)
#pragma unroll
                for (int m = 0; m < 4; ++m) { const int row = row0 + ai * 128 + m * 16; bf16_t* rowp = base + (size_t)row * ldc + col0; float s1 = 0.f, s2 = 0.f;
#pragma unroll
                    for (int bj = 0; bj < 2; ++bj) { const f32x4 v0 = acc[ai][bj][m][0], v1 = acc[ai][bj][m][1];
                        const float a0 = gelu_tanh(v0[0]), a1 = gelu_tanh(v0[1]), a2 = gelu_tanh(v0[2]), a3 = gelu_tanh(v0[3]), a4 = gelu_tanh(v1[0]), a5 = gelu_tanh(v1[1]), a6 = gelu_tanh(v1[2]), a7 = gelu_tanh(v1[3]);
                        s1 += ((a0 + a1) + (a2 + a3)) + ((a4 + a5) + (a6 + a7)); s2 += ((a0 * a0 + a1 * a1) + (a2 * a2 + a3 * a3)) + ((a4 * a4 + a5 * a5) + (a6 * a6 + a7 * a7));
                        v4u w; w.x = cvt_pk_bf16(a0, a1); w.y = cvt_pk_bf16(a2, a3); w.z = cvt_pk_bf16(a4, a5); w.w = cvt_pk_bf16(a6, a7); *(v4u*)(rowp + bj * 128) = w; }
                    s1 += __shfl_xor(s1, 16); s1 += __shfl_xor(s1, 32); s2 += __shfl_xor(s2, 16); s2 += __shfl_xor(s2, 32);
                    if (fq_ == 0) { float2 st2; st2.x = s1; st2.y = s2; *(float2*)(VST + ((size_t)row * 32 + (pn - 20) * 4 + wc) * 2) = st2; } }
        }
    }
};
template <int ACT> __device__ __forceinline__ void store_tile_i8(const pg8::i32x4 (&acc)[2][2][4][2], bf16_t* base, int ldc, int row0, int col0, const float* hs1, const float* sp) {
    f32x4 sc[2][2];
#pragma unroll
    for (int bj = 0; bj < 2; ++bj) { sc[bj][0] = *(const f32x4*)(sp + bj * 128); sc[bj][1] = *(const f32x4*)(sp + bj * 128 + 4); }
#pragma unroll
    for (int ai = 0; ai < 2; ++ai)
#pragma unroll
        for (int m = 0; m < 4; ++m) { const int row = row0 + ai * 128 + m * 16; const float xr = hs1[row]; bf16_t* rowp = base + (size_t)row * ldc + col0;
#pragma unroll
            for (int bj = 0; bj < 2; ++bj) { const pg8::i32x4 i0 = acc[ai][bj][m][0], i1 = acc[ai][bj][m][1];
                const f32x4 z0 = (f32x4){(float)i0[0], (float)i0[1], (float)i0[2], (float)i0[3]} * sc[bj][0] * xr, z1 = (f32x4){(float)i1[0], (float)i1[1], (float)i1[2], (float)i1[3]} * sc[bj][1] * xr; v4u w;
                if constexpr (ACT == 3) {
                    unsigned lo = 0u, hi = 0u;
                    lo = __builtin_amdgcn_cvt_pk_u8_f32(rintf(255.0f * sigmoid_f(z0[0])), 0, lo); lo = __builtin_amdgcn_cvt_pk_u8_f32(rintf(255.0f * sigmoid_f(z0[1])), 1, lo); lo = __builtin_amdgcn_cvt_pk_u8_f32(rintf(255.0f * sigmoid_f(z0[2])), 2, lo); lo = __builtin_amdgcn_cvt_pk_u8_f32(rintf(255.0f * sigmoid_f(z0[3])), 3, lo);
                    hi = __builtin_amdgcn_cvt_pk_u8_f32(rintf(255.0f * sigmoid_f(z1[0])), 0, hi); hi = __builtin_amdgcn_cvt_pk_u8_f32(rintf(255.0f * sigmoid_f(z1[1])), 1, hi); hi = __builtin_amdgcn_cvt_pk_u8_f32(rintf(255.0f * sigmoid_f(z1[2])), 2, hi); hi = __builtin_amdgcn_cvt_pk_u8_f32(rintf(255.0f * sigmoid_f(z1[3])), 3, hi);
                    *(v2u*)((unsigned char*)base + (size_t)row * ldc + col0 + bj * 128) = (v2u){lo, hi}; continue; }
                w.x = cvt_pk_bf16(act_f<ACT>(z0[0]), act_f<ACT>(z0[1])); w.y = cvt_pk_bf16(act_f<ACT>(z0[2]), act_f<ACT>(z0[3])); w.z = cvt_pk_bf16(act_f<ACT>(z1[0]), act_f<ACT>(z1[1])); w.w = cvt_pk_bf16(act_f<ACT>(z1[2]), act_f<ACT>(z1[3]));
                *(v4u*)(rowp + bj * 128) = w; } }
}
struct EpiGate {
    bf16_t *Q, *Kb, *Vb, *U, *VG, *GA, *GS; float* VST; const float* hs1; const float* swin; const float* gq; const float* gk; LAS float* P;
    __device__ __forceinline__ void operator()(const pg8::i32x4 (&acc)[2][2][4][2], const Unit& u, int wr, int wc, int fr, int fq) const {
        asm volatile("" : "+v"(fr), "+v"(fq));
        const int pn = u.pn; bf16_t* base; int ldc, colt;
        if (pn < 8) { base = Q; ldc = D; colt = pn * 256; }
        else if (pn < 10) { base = Kb; ldc = KVW; colt = (pn - 8) * 256; }
        else if (pn < 12) { base = Vb; ldc = KVW; colt = (pn - 10) * 256; }
        else if (pn < 20) { base = U; ldc = D; colt = (pn - 12) * 256; }
        else if (pn < 28) { base = VG; ldc = D; colt = (pn - 20) * 256; }
        else if (pn < 36) { base = GA; ldc = D; colt = (pn - 28) * 256; }
        else { base = GS; ldc = D; colt = (pn - 36) * 256; }
        const int row0 = u.pm * 256 + wr * 64 + fr, col0 = colt + wc * 32 + 8 * fq; const float* sp = swin + pn * 256 + wc * 32 + 8 * fq;
        if (pn < 10) {
            f32x4 sc[2][2];
#pragma unroll
            for (int bj = 0; bj < 2; ++bj) { sc[bj][0] = *(const f32x4*)(sp + bj * 128); sc[bj][1] = *(const f32x4*)(sp + bj * 128 + 4); }
#pragma unroll
            for (int ai = 0; ai < 2; ++ai)
#pragma unroll
                for (int m = 0; m < 4; ++m) { const int rl = ai * 128 + wr * 64 + m * 16 + fr; const float xr = hs1[u.pm * 256 + rl];
#pragma unroll
                    for (int bj = 0; bj < 2; ++bj) { const pg8::i32x4 i0 = acc[ai][bj][m][0], i1 = acc[ai][bj][m][1];
                        const f32x4 z0 = (f32x4){(float)i0[0], (float)i0[1], (float)i0[2], (float)i0[3]} * sc[bj][0] * xr, z1 = (f32x4){(float)i1[0], (float)i1[1], (float)i1[2], (float)i1[3]} * sc[bj][1] * xr;
                        float ss = ((z0[0] * z0[0] + z0[1] * z0[1]) + (z0[2] * z0[2] + z0[3] * z0[3])) + ((z1[0] * z1[0] + z1[1] * z1[1]) + (z1[2] * z1[2] + z1[3] * z1[3]));
                        ss += __shfl_xor(ss, 16); ss += __shfl_xor(ss, 32);
                        if (fq == 0) P[(rl * 2 + bj) * 4 + wc] = ss; } }
            asm volatile("s_waitcnt lgkmcnt(0)" ::: "memory"); __builtin_amdgcn_s_barrier(); asm volatile("" ::: "memory");
            if (pn < 8) { const int d = wc * 32 + 8 * fq; const f32x4 g0 = *(const f32x4*)(gq + d) * *(const f32x4*)(gk + d) * (0.08838834764831845f * 1.4426950408889634f), g1 = *(const f32x4*)(gq + d + 4) * *(const f32x4*)(gk + d + 4) * (0.08838834764831845f * 1.4426950408889634f);
#pragma unroll
                for (int bj = 0; bj < 2; ++bj) { sc[bj][0] *= g0; sc[bj][1] *= g1; } }
#pragma unroll
            for (int ai = 0; ai < 2; ++ai)
#pragma unroll
                for (int m = 0; m < 4; ++m) { const int rl = ai * 128 + wr * 64 + m * 16 + fr; const int row = u.pm * 256 + rl; const float xr = hs1[row]; bf16_t* rowp = base + (size_t)row * ldc + col0;
#pragma unroll
                    for (int bj = 0; bj < 2; ++bj) { const pg8::i32x4 i0 = acc[ai][bj][m][0], i1 = acc[ai][bj][m][1]; const f32x4 pp = *(const LAS f32x4*)(P + (rl * 2 + bj) * 4);
                        const float rn = (1.0f / sqrtf(((pp.x + pp.y) + (pp.z + pp.w)) * (1.0f / 128.0f) + NORM_EPS)) * xr;
                        const f32x4 z0 = (f32x4){(float)i0[0], (float)i0[1], (float)i0[2], (float)i0[3]} * sc[bj][0] * rn, z1 = (f32x4){(float)i1[0], (float)i1[1], (float)i1[2], (float)i1[3]} * sc[bj][1] * rn; v4u w;
                        w.x = cvt_pk_bf16(z0[0], z0[1]); w.y = cvt_pk_bf16(z0[2], z0[3]); w.z = cvt_pk_bf16(z1[0], z1[1]); w.w = cvt_pk_bf16(z1[2], z1[3]);
                        *(v4u*)(rowp + bj * 128) = w; } }
        }
        else if (pn < 12) store_tile_i8<0>(acc, base, ldc, row0, col0, hs1, sp);
        else if (pn < 20) store_tile_i8<1>(acc, base, ldc, row0, col0, hs1, sp);
        else if (pn >= 28) store_tile_i8<3>(acc, base, ldc, row0, col0, hs1, sp);
        else {
            f32x4 sc[2][2];
#pragma unroll
            for (int bj = 0; bj < 2; ++bj) { sc[bj][0] = *(const f32x4*)(sp + bj * 128); sc[bj][1] = *(const f32x4*)(sp + bj * 128 + 4); }
#pragma unroll
            for (int ai = 0; ai < 2; ++ai)
#pragma unroll
                for (int m = 0; m < 4; ++m) { const unsigned row = (unsigned)(row0 + ai * 128 + m * 16); const float xr = *(const float*)((const char*)hs1 + (size_t)(row * 4u));
                    bf16_t* rowp = (bf16_t*)((char*)base + (size_t)((row * (unsigned)ldc + (unsigned)col0) * 2u)); float s1 = 0.f, s2 = 0.f;
#pragma unroll
                    for (int bj = 0; bj < 2; ++bj) { const pg8::i32x4 i0 = acc[ai][bj][m][0], i1 = acc[ai][bj][m][1];
                        const f32x4 z0 = (f32x4){(float)i0[0], (float)i0[1], (float)i0[2], (float)i0[3]} * sc[bj][0] * xr, z1 = (f32x4){(float)i1[0], (float)i1[1], (float)i1[2], (float)i1[3]} * sc[bj][1] * xr;
                        const float a0 = gelu_tanh(z0[0]), a1 = gelu_tanh(z0[1]), a2 = gelu_tanh(z0[2]), a3 = gelu_tanh(z0[3]), a4 = gelu_tanh(z1[0]), a5 = gelu_tanh(z1[1]), a6 = gelu_tanh(z1[2]), a7 = gelu_tanh(z1[3]);
                        s1 += ((a0 + a1) + (a2 + a3)) + ((a4 + a5) + (a6 + a7)); s2 += ((a0 * a0 + a1 * a1) + (a2 * a2 + a3 * a3)) + ((a4 * a4 + a5 * a5) + (a6 * a6 + a7 * a7));
                        v4u w; w.x = cvt_pk_bf16(a0, a1); w.y = cvt_pk_bf16(a2, a3); w.z = cvt_pk_bf16(a4, a5); w.w = cvt_pk_bf16(a6, a7); *(v4u*)(rowp + bj * 128) = w; }
                    s1 += __shfl_xor(s1, 16); s1 += __shfl_xor(s1, 32); s2 += __shfl_xor(s2, 16); s2 += __shfl_xor(s2, 32);
                    if (fq == 0) { float2 st2; st2.x = s1; st2.y = s2; *(float2*)((char*)VST + (size_t)((row * 32u + (unsigned)((pn - 20) * 4 + wc)) * 8u)) = st2; } }
        }
    }
};
struct EpiMerge {
    bf16_t* T; const unsigned char* G8; const float* wsco; int half;
    __device__ __forceinline__ void operator()(const f32x4 (&acc)[2][2][4][2], const Unit& u, int wr, int wc, int fr, int fq) const {
        const int row0 = u.pm * 256 + wr * 64 + fr, col0 = u.pn * 256 + wc * 32 + 8 * fq;
        f32x4 cs[2][2];
#pragma unroll
        for (int bj = 0; bj < 2; ++bj) { cs[bj][0] = (half == 0 ? *(const f32x4*)(wsco + col0 + bj * 128) : (f32x4){1.f, 1.f, 1.f, 1.f}) * (1.0f / 255.0f); cs[bj][1] = (half == 0 ? *(const f32x4*)(wsco + col0 + bj * 128 + 4) : (f32x4){1.f, 1.f, 1.f, 1.f}) * (1.0f / 255.0f); }
#pragma unroll
        for (int ai = 0; ai < 2; ++ai)
#pragma unroll
            for (int m = 0; m < 4; ++m) { const size_t off = (size_t)(row0 + ai * 128 + m * 16) * D + col0;
#pragma unroll
                for (int bj = 0; bj < 2; ++bj) { const f32x4 v0 = acc[ai][bj][m][0] * cs[bj][0], v1 = acc[ai][bj][m][1] * cs[bj][1];
                    const v2u g = *(const v2u*)(G8 + off + bj * 128);
                    f32x4 r0 = (f32x4){(float)(g.x & 255u), (float)((g.x >> 8) & 255u), (float)((g.x >> 16) & 255u), (float)(g.x >> 24)} * v0, r1 = (f32x4){(float)(g.y & 255u), (float)((g.y >> 8) & 255u), (float)((g.y >> 16) & 255u), (float)(g.y >> 24)} * v1;
                    if (half) { const v4u t = *(const v4u*)(T + off + bj * 128); r0 += (f32x4){bf_lo(t.x), bf_hi(t.x), bf_lo(t.y), bf_hi(t.y)}; r1 += (f32x4){bf_lo(t.z), bf_hi(t.z), bf_lo(t.w), bf_hi(t.w)}; }
                    v4u w; w.x = cvt_pk_bf16(r0[0], r0[1]); w.y = cvt_pk_bf16(r0[2], r0[3]); w.z = cvt_pk_bf16(r1[0], r1[1]); w.w = cvt_pk_bf16(r1[2], r1[3]);
                    *(v4u*)(T + off + bj * 128) = w; } }
    }
};
struct EpiOut {
    const float* xp; const float* xs; float* out; const float* mod; const float* ms; const float* swo;
    __device__ __forceinline__ void operator()(const pg8::i32x4 (&acc)[2][2][4][2], const Unit& u, int wr, int wc, int fr, int fq) const {
        asm volatile("" : "+v"(fr), "+v"(fq));
        const int row0 = u.pm * 256 + wr * 64 + fr, col0 = u.pn * 256 + wc * 32 + 8 * fq;
        const int s = seq_of(u.pm * 256);
        const float* xb = u.pm < TP / 256 ? xp : xs - (size_t)TP * D;
        f32x4 g[2][2];
#pragma unroll
        for (int bj = 0; bj < 2; ++bj)
#pragma unroll
            for (int n = 0; n < 2; ++n) g[bj][n] = *(const f32x4*)(mod + (size_t)s * MODW + 2 * D + col0 + bj * 128 + 4 * n) * *(const f32x4*)(swo + col0 + bj * 128 + 4 * n);
#pragma unroll
        for (int ai = 0; ai < 2; ++ai)
#pragma unroll
            for (int m = 0; m < 4; ++m) { const int row = row0 + ai * 128 + m * 16; const size_t off = (size_t)row * D + col0; const float mr = ms[row];
#pragma unroll
                for (int bj = 0; bj < 2; ++bj)
#pragma unroll
                    for (int n = 0; n < 2; ++n) { const f32x4 xv = *(const f32x4*)(xb + off + bj * 128 + 4 * n); const pg8::i32x4 ia = acc[ai][bj][m][n];
                        *(f32x4*)(out + off + bj * 128 + 4 * n) = xv + g[bj][n] * ((f32x4){(float)ia[0], (float)ia[1], (float)ia[2], (float)ia[3]} * mr); } }
    }
};
struct EpiGU {
    unsigned char* ACT; const float* xs; const float* sgu;
    __device__ __forceinline__ void operator()(const pg8::i32x4 (&acc)[2][2][4][2], const Unit& u, int wr, int wc, int fr, int fq) const {
        const int row0 = u.pm * 256 + wr * 64 + fr, col0 = u.pn * 128 + wc * 32 + 8 * fq;
        const float* sp = sgu + (size_t)(u.aux * 22 + u.pn) * 256 + wc * 32 + 8 * fq;
        const f32x4 sg0 = *(const f32x4*)sp, sg1 = *(const f32x4*)(sp + 4), su0 = *(const f32x4*)(sp + 128), su1 = *(const f32x4*)(sp + 132);
#pragma unroll
        for (int ai = 0; ai < 2; ++ai)
#pragma unroll
            for (int m = 0; m < 4; ++m) { const int row = row0 + ai * 128 + m * 16; const float xr = xs[row]; unsigned char* rowp = ACT + (size_t)row * FF + col0;
                const pg8::i32x4 gi0 = acc[ai][0][m][0], gi1 = acc[ai][0][m][1], ui0 = acc[ai][1][m][0], ui1 = acc[ai][1][m][1];
                const f32x4 g0 = {(float)gi0[0], (float)gi0[1], (float)gi0[2], (float)gi0[3]}, g1 = {(float)gi1[0], (float)gi1[1], (float)gi1[2], (float)gi1[3]};
                const f32x4 u0 = {(float)ui0[0], (float)ui0[1], (float)ui0[2], (float)ui0[3]}, u1 = {(float)ui1[0], (float)ui1[1], (float)ui1[2], (float)ui1[3]};
                const f32x4 a0 = g0 * sg0 * xr, a1 = g1 * sg1 * xr, b0 = u0 * su0 * xr, b1 = u1 * su1 * xr; v2u w; unsigned t = 0u;
                t = __builtin_amdgcn_cvt_pk_fp8_f32(a0[0] * sigmoid_f(a0[0]) * b0[0], a0[1] * sigmoid_f(a0[1]) * b0[1], t, false); t = __builtin_amdgcn_cvt_pk_fp8_f32(a0[2] * sigmoid_f(a0[2]) * b0[2], a0[3] * sigmoid_f(a0[3]) * b0[3], t, true); w.x = t;
                t = __builtin_amdgcn_cvt_pk_fp8_f32(a1[0] * sigmoid_f(a1[0]) * b1[0], a1[1] * sigmoid_f(a1[1]) * b1[1], t, false); t = __builtin_amdgcn_cvt_pk_fp8_f32(a1[2] * sigmoid_f(a1[2]) * b1[2], a1[3] * sigmoid_f(a1[3]) * b1[3], t, true); w.y = t;
                *(v2u*)rowp = w; }
    }
};
constexpr float Y_SCALE = 16.0f;
struct EpiDown {
    bf16_t* Y; const float* selw; const float* wsc;
    __device__ __forceinline__ void operator()(const f32x4 (&acc)[2][2][4][2], const Unit& u, int wr, int wc, int fr, int fq) const {
        const int row0 = u.pm * 256 + wr * 64 + fr, col0 = u.pn * 256 + wc * 32 + 8 * fq; const float* cp = wsc + (size_t)u.aux * D + col0; f32x4 cs[2][2];
#pragma unroll
        for (int bj = 0; bj < 2; ++bj) { cs[bj][0] = *(const f32x4*)(cp + bj * 128); cs[bj][1] = *(const f32x4*)(cp + bj * 128 + 4); }
#pragma unroll
        for (int ai = 0; ai < 2; ++ai)
#pragma unroll
            for (int m = 0; m < 4; ++m) { const int row = row0 + ai * 128 + m * 16; const float wv = selw[row] * Y_SCALE; unsigned char* rowp = (unsigned char*)Y + (size_t)row * D + col0;
#pragma unroll
                for (int bj = 0; bj < 2; ++bj) { const f32x4 v0 = acc[ai][bj][m][0] * cs[bj][0] * wv, v1 = acc[ai][bj][m][1] * cs[bj][1] * wv; v2u w; unsigned t = 0u;
#define YC(x) __builtin_amdgcn_fmed3f((x), -448.0f, 448.0f)
                    t = __builtin_amdgcn_cvt_pk_fp8_f32(YC(v0[0]), YC(v0[1]), t, false); t = __builtin_amdgcn_cvt_pk_fp8_f32(YC(v0[2]), YC(v0[3]), t, true); w.x = t;
                    t = __builtin_amdgcn_cvt_pk_fp8_f32(YC(v1[0]), YC(v1[1]), t, false); t = __builtin_amdgcn_cvt_pk_fp8_f32(YC(v1[2]), YC(v1[3]), t, true); w.y = t;
#undef YC
                    *(v2u*)(rowp + bj * 128) = w; } }
    }
};

struct SchedGrid {
    const char* A; const char* B; size_t tstep; int nM, nN, G, c;
    __device__ __forceinline__ bool next(int i, Unit& u) const { const long L = (long)i * G + c; if (L >= (long)nM * nN) return false;
        int pm, pn; pg8::tile_of((int)L, nM, nN, pm, pn); u.pm = pm; u.pn = pn; u.aux = 0; u.idx = nullptr; u.a = A + (size_t)pm * tstep; u.b = B + (size_t)pn * tstep; return true; }
};
struct SchedGridMap {
    const char* A; const char* B; size_t tstep; int nM, nN, G, c, split, ofs0, ofs1;
    __device__ __forceinline__ bool next(int i, Unit& u) const { const long L = (long)i * G + c; if (L >= (long)nM * nN) return false;
        int pm, pj; pg8::tile_of((int)L, nM, nN, pm, pj); const int pn = pj < split ? pj + ofs0 : pj + ofs1; u.pm = pm; u.pn = pn; u.aux = 0; u.a = A + (size_t)pm * tstep; u.b = B + (size_t)pn * tstep; return true; }
};
struct SchedPair {
    const char *A0, *A1, *B0, *B1; size_t tstep; int nM, nN, G, c;
    __device__ __forceinline__ bool next(int i, Unit& u) const { const long L = (long)(i >> 1) * G + c; if (L >= (long)nM * nN) return false;
        int pm, pn; pg8::tile_of((int)L, nM, nN, pm, pn); u.pm = pm; u.pn = pn; u.aux = i & 1;
        u.a = ((i & 1) ? A1 : A0) + (size_t)pm * tstep; u.b = ((i & 1) ? B1 : B0) + (size_t)pn * tstep; return true; }
};
struct SchedMoe {
    const char* A; const char* B; size_t atstep, btstep; int NT, G, c; const int* idx;
    __device__ __forceinline__ bool next(int i, Unit& u) const { const long L = (long)i * G + c; const int per = 24 * NT; if (L >= (long)NE * per) return false;
        const int e = (int)(L / per), r = (int)(L % per), mt = r % 24, nt = r / 24;
        const int pm = mt < 8 ? e * 8 + mt : 128 + e * 16 + (mt - 8);
        u.pm = pm; u.pn = nt; u.aux = e; u.idx = idx ? idx + pm * 256 : nullptr; u.a = idx ? A : A + (size_t)pm * atstep; u.b = B + (size_t)(e * NT + nt) * btstep; return true; }
};

typedef short bf16x8_t __attribute__((ext_vector_type(8)));
typedef short s16x4_t __attribute__((ext_vector_type(4)));
typedef float f32x16 __attribute__((ext_vector_type(16)));
typedef float f32x2_t __attribute__((ext_vector_type(2)));
typedef __bf16 bf16x2_t __attribute__((ext_vector_type(2)));
__device__ __forceinline__ unsigned cvt2(float lo, float hi) { const f32x2_t v = {lo, hi}; const bf16x2_t b2 = __builtin_convertvector(v, bf16x2_t); return __builtin_bit_cast(unsigned, b2); }
constexpr int AT_KS = 272, AT_VS = 320, AT_KB = 64 * AT_KS, AT_VB = 64 * AT_VS, AT_BUF = AT_KB + AT_VB;
constexpr int AT_GQK = AUX_OFF;
__device__ __forceinline__ void attn_unit(const Frame& F, int qb, int hk) {
    const int lane = F.lane, tid = F.tid, w = F.wave, g = w >> 1, j = w & 1, c = lane & 31, h = lane >> 5, l15 = lane & 15, grp = (lane >> 4) & 1;
    const int R0 = qb * 64, s = seq_of(R0), t0 = seq_start(s), L = seq_len(s), P0 = R0 - t0, head = 4 * hk + g;
    bf16* Qb = (bf16*)(F.ws + WS_Q); const bf16* Kb = (const bf16*)((unsigned char*)F.out + DO_K); const bf16* Vb = (const bf16*)((unsigned char*)F.out + DO_V);
    const LAS float* gqk = (const LAS float*)(F.lds + AT_GQK);
    constexpr float LOG2E = 1.4426950408889634f;
    float gmax = fmaxf(fabsf(gqk[lane]), fabsf(gqk[lane + 64])); gmax = wave_max(gmax);
    const float sinkv = F.in[11][head];
    const float M2 = fmaxf(11.313708499f * gmax, sinkv) * LOG2E, slope2 = exp2f(-0.5f * (float)(head + 1)) * LOG2E;
    bf16x8_t qf[8];
    { const bf16* qrow = Qb + (size_t)(R0 + 32 * j + c) * D + head * 128 + 8 * h;
#pragma unroll
      for (int ks = 0; ks < 8; ++ks) qf[ks] = __builtin_bit_cast(bf16x8_t, *(const v4u*)(qrow + 16 * ks)); }
    f32x16 o[4];
#pragma unroll
    for (int dt = 0; dt < 4; ++dt)
#pragma unroll
        for (int i = 0; i < 16; ++i) o[dt][i] = 0.f;
    float lsum = 0.f;
    const int c_lo = P0 >= 128 ? 0 : (P0 >= 64 ? 1 : 2), c_hi = (P0 + 192 <= L) ? 4 : ((P0 + 128 <= L) ? 3 : 2);
    LAS unsigned char* ring = F.lds + RING_OFF;
    v4u kr[2], vr[2];
#define AT_LOAD(cc) do { const int kp = P0 - 128 + 64 * (cc); _Pragma("unroll") for (int i = 0; i < 2; ++i) { const int p = tid + 512 * i; const size_t off = (size_t)(t0 + kp + (p >> 4)) * KVW + hk * 128 + (p & 15) * 8; \
        kr[i] = *(const v4u*)(Kb + off); vr[i] = *(const v4u*)(Vb + off); } } while (0)
#define AT_WRITE(bufi) do { LAS unsigned char* kb_ = ring + (bufi) * AT_BUF; LAS unsigned char* vb_ = kb_ + AT_KB; _Pragma("unroll") for (int i = 0; i < 2; ++i) { const int p = tid + 512 * i, key = p >> 4, dd = (p & 15) * 8; \
        *(LAS v4u*)(kb_ + key * AT_KS + dd * 2) = kr[i]; *(LAS v4u*)(vb_ + key * AT_VS + dd * 2) = vr[i]; } } while (0)
    AT_LOAD(c_lo); AT_WRITE(0);
    __syncthreads();
    for (int cc = c_lo; cc <= c_hi; ++cc) {
        const int bi = (cc - c_lo) & 1;
        if (cc < c_hi) AT_LOAD(cc + 1);
        const LAS unsigned char* kbuf = ring + bi * AT_BUF; const LAS unsigned char* vbuf = kbuf + AT_KB;
#pragma unroll
        for (int u = 0; u < 2; ++u) {
            const int tt = 2 * cc + u;
            if (tt >= j && tt <= j + 8) {
                const int d0 = -128 + 32 * (tt - j);
                f32x16 sacc;
#pragma unroll
                for (int i = 0; i < 16; ++i) sacc[i] = 0.f;
#pragma unroll
                for (int ks = 0; ks < 8; ++ks) { const bf16x8_t kf = *(const LAS bf16x8_t*)(kbuf + (32 * u + c) * AT_KS + (16 * ks + 8 * h) * 2);
                    sacc = __builtin_amdgcn_mfma_f32_32x32x16_bf16(kf, qf[ks], sacc, 0, 0, 0); }
                const float relb = (float)(d0 - c + 4 * h); const int keyb = 4 * h;
                unsigned pk[8];
#pragma unroll
                for (int i2 = 0; i2 < 8; ++i2) { float pe[2];
#pragma unroll
                    for (int q = 0; q < 2; ++q) { const int i = 2 * i2 + q, ko = (i & 3) + 8 * (i >> 2);
                        float v = __builtin_amdgcn_exp2f(sacc[i] - slope2 * fabsf(relb + (float)ko) - M2);
                        if (d0 == -128) v = (keyb + ko >= c) ? v : 0.f;
                        if (d0 == 128) v = (keyb + ko <= c) ? v : 0.f;
                        lsum += v; pe[q] = v; }
                    pk[i2] = cvt2(pe[0], pe[1]); }
                const bf16x8_t pf0 = __builtin_bit_cast(bf16x8_t, (v4u){pk[0], pk[1], pk[2], pk[3]}), pf1 = __builtin_bit_cast(bf16x8_t, (v4u){pk[4], pk[5], pk[6], pk[7]});
                const LAS unsigned char* vrow = vbuf + (32 * u + 4 * h + (l15 >> 2)) * AT_VS + (16 * grp) * 2 + (l15 & 3) * 8;
#pragma unroll
                for (int dt = 0; dt < 4; ++dt) {
#pragma unroll
                    for (int sx = 0; sx < 2; ++sx) { const LAS unsigned char* vp = vrow + (16 * sx) * AT_VS + dt * 64;
                        const s16x4_t lo = __builtin_bit_cast(s16x4_t, __builtin_amdgcn_ds_read_tr16_b64_v4i16((LAS s16x4_t*)vp));
                        const s16x4_t hi = __builtin_bit_cast(s16x4_t, __builtin_amdgcn_ds_read_tr16_b64_v4i16((LAS s16x4_t*)(vp + 8 * AT_VS)));
                        const bf16x8_t vf = {lo[0], lo[1], lo[2], lo[3], hi[0], hi[1], hi[2], hi[3]};
                        o[dt] = __builtin_amdgcn_mfma_f32_32x32x16_bf16(vf, sx ? pf1 : pf0, o[dt], 0, 0, 0); } }
            }
        }
        if (cc < c_hi) AT_WRITE(bi ^ 1);
        __syncthreads();
    }
#undef AT_LOAD
#undef AT_WRITE
    lsum += __shfl_xor(lsum, 32);
    const float inv = 1.0f / (lsum + __builtin_amdgcn_exp2f(sinkv * LOG2E - M2));
    unsigned char* orow = F.ws + WS_ATT8 + (size_t)(R0 + 32 * j + c) * D + head * 128 + 4 * h;
#pragma unroll
    for (int dt = 0; dt < 4; ++dt)
#pragma unroll
        for (int gi = 0; gi < 4; ++gi) { unsigned t = 0u; t = __builtin_amdgcn_cvt_pk_fp8_f32(o[dt][4 * gi] * inv, o[dt][4 * gi + 1] * inv, t, false); t = __builtin_amdgcn_cvt_pk_fp8_f32(o[dt][4 * gi + 2] * inv, o[dt][4 * gi + 3] * inv, t, true);
            *(unsigned*)(orow + 32 * dt + 8 * gi) = t; }
}
constexpr int SG_VS = 320, SG_WS = 272, SG_MS = 272, SG_VN = 0, SG_W = 128 * SG_VS, SG_MIX = SG_W + 128 * SG_WS;
__device__ __forceinline__ void sgu_unit(const Frame& F, int chunk, int gquad) {
    LAS unsigned char* ring = F.lds + RING_OFF;
    LAS float* st = (LAS float*)(F.lds + AUX_OFF + 1024);
    bf16* U = (bf16*)(F.ws + WS_U); const bf16* VG = (const bf16*)(F.ws + WS_VG); const bf16* SW = (const bf16*)(F.ws + WS_SGW);
    const float* vst = (const float*)((unsigned char*)F.out + DO_VST);
    const float* lng = F.in[12]; const float* lnb = F.in[13]; const float* sb = F.in[15];
    const int row0 = chunk * 128, tid = F.tid, lane = F.lane, w = F.wave, c31 = lane & 31, h = lane >> 5, l15 = lane & 15, grp = (lane >> 4) & 1;
    { const int r = tid >> 2, q = tid & 3; const f32x4* p = (const f32x4*)(vst + ((size_t)(row0 + r) * 32 + q * 8) * 2); float s1 = 0.f, s2 = 0.f;
#pragma unroll
      for (int i = 0; i < 4; ++i) { const f32x4 x = p[i]; s1 += x.x + x.z; s2 += x.y + x.w; }
      s1 += __shfl_xor(s1, 1); s1 += __shfl_xor(s1, 2); s2 += __shfl_xor(s2, 1); s2 += __shfl_xor(s2, 2);
      const float mean = s1 * (1.0f / D), var = fmaxf(s2 * (1.0f / D) - mean * mean, 0.f);
      if (q == 0) { st[2 * r] = mean; st[2 * r + 1] = 1.0f / sqrtf(var + NORM_EPS); } }
    __syncthreads();
    const int sr = tid >> 4, sc = (tid & 15) * 8;
    const int ct = w & 3, th = w >> 2;
    for (int gi = 0; gi < 4; ++gi) {
        const int g = gquad * 4 + gi;
        v4u xv[4], wv[4], uv[4];
#pragma unroll
        for (int q = 0; q < 4; ++q) { const int r = sr + 32 * q; xv[q] = *(const v4u*)(VG + (size_t)(row0 + r) * D + g * 128 + sc); wv[q] = *(const v4u*)(SW + (size_t)g * 16384 + r * 128 + sc);
            uv[q] = *(const v4u*)(U + (size_t)(row0 + r) * D + g * 128 + sc); }
        { const f32x4 ga = *(const f32x4*)(lng + g * 128 + sc), gb = *(const f32x4*)(lng + g * 128 + sc + 4), ba = *(const f32x4*)(lnb + g * 128 + sc), bb = *(const f32x4*)(lnb + g * 128 + sc + 4);
#pragma unroll
          for (int q = 0; q < 4; ++q) { const int r = sr + 32 * q; const float mean = st[2 * r], rstd = st[2 * r + 1]; const v4u x = xv[q];
              const f32x4 fa = {bf_lo(x.x), bf_hi(x.x), bf_lo(x.y), bf_hi(x.y)}, fb = {bf_lo(x.z), bf_hi(x.z), bf_lo(x.w), bf_hi(x.w)};
              const f32x4 ya = (fa - mean) * rstd * ga + ba, yb = (fb - mean) * rstd * gb + bb;
              v4u o; o.x = cvt2(ya.x, ya.y); o.y = cvt2(ya.z, ya.w); o.z = cvt2(yb.x, yb.y); o.w = cvt2(yb.z, yb.w);
              *(LAS v4u*)(ring + SG_VN + r * SG_VS + sc * 2) = o; *(LAS v4u*)(ring + SG_W + r * SG_WS + sc * 2) = wv[q]; } }
        __syncthreads();
        f32x16 acc[2];
#pragma unroll
        for (int x = 0; x < 2; ++x)
#pragma unroll
            for (int i = 0; i < 16; ++i) acc[x][i] = 0.f;
        { const LAS unsigned char* vrow = ring + SG_VN + (8 * h + (l15 >> 2)) * SG_VS + (32 * ct + 16 * grp) * 2 + (l15 & 3) * 8;
          const LAS unsigned char* wrow = ring + SG_W + (64 * th + c31) * SG_WS + (8 * h) * 2;
#pragma unroll
          for (int ks = 0; ks < 8; ++ks) {
              const s16x4_t lo = __builtin_bit_cast(s16x4_t, __builtin_amdgcn_ds_read_tr16_b64_v4i16((LAS s16x4_t*)(vrow + (16 * ks) * SG_VS)));
              const s16x4_t hi = __builtin_bit_cast(s16x4_t, __builtin_amdgcn_ds_read_tr16_b64_v4i16((LAS s16x4_t*)(vrow + (16 * ks + 4) * SG_VS)));
              const bf16x8_t af = {lo[0], lo[1], lo[2], lo[3], hi[0], hi[1], hi[2], hi[3]};
#pragma unroll
              for (int x = 0; x < 2; ++x) { const bf16x8_t bfr = *(const LAS bf16x8_t*)(wrow + (32 * x) * SG_WS + (16 * ks) * 2);
                  acc[x] = __builtin_amdgcn_mfma_f32_32x32x16_bf16(af, bfr, acc[x], 0, 0, 0); } } }
#pragma unroll
        for (int x = 0; x < 2; ++x) { const int t = 64 * th + 32 * x + c31; const float bias = sb[g * 128 + t];
#pragma unroll
            for (int q4 = 0; q4 < 4; ++q4) { v2u o; o.x = cvt2(acc[x][4 * q4] + bias, acc[x][4 * q4 + 1] + bias); o.y = cvt2(acc[x][4 * q4 + 2] + bias, acc[x][4 * q4 + 3] + bias);
                *(LAS v2u*)(ring + SG_MIX + t * SG_MS + (32 * ct + 8 * q4 + 4 * h) * 2) = o; } }
        __syncthreads();
#pragma unroll
        for (int q = 0; q < 4; ++q) { const int r = sr + 32 * q; const v4u m8 = *(const LAS v4u*)(ring + SG_MIX + r * SG_MS + sc * 2); const v4u u8 = uv[q]; v4u o;
            o.x = cvt2(bf_lo(u8.x) * bf_lo(m8.x), bf_hi(u8.x) * bf_hi(m8.x)); o.y = cvt2(bf_lo(u8.y) * bf_lo(m8.y), bf_hi(u8.y) * bf_hi(m8.y));
            o.z = cvt2(bf_lo(u8.z) * bf_lo(m8.z), bf_hi(u8.z) * bf_hi(m8.z)); o.w = cvt2(bf_lo(u8.w) * bf_lo(m8.w), bf_hi(u8.w) * bf_hi(m8.w));
            *(v4u*)(U + (size_t)(row0 + r) * D + g * 128 + sc) = o; }
    }
    __syncthreads();
}

template <int PER> __device__ __forceinline__ void topk_body(const Frame& F, int g, int e) {
    constexpr int T = PER * 512, C = T / 8; const int tid = F.tid, lane = F.lane, w = F.wave;
    const float* vals = (const float*)(F.ws + WS_AFFT) + (g ? (size_t)NE * TP + (size_t)e * TS : (size_t)e * TP);
    LAS unsigned* lv = (LAS unsigned*)(F.lds + RING_OFF);
    LAS unsigned* red = (LAS unsigned*)(F.lds + AUX_OFF + 8192);
    LAS unsigned* cg = red + 64; LAS unsigned* ce = red + 64 + 520;
    for (int i = tid; i < T; i += 512) lv[i + (i >> 5)] = __float_as_uint(vals[i]);
    __syncthreads();
    unsigned v[PER]; const int i0 = tid * PER;
#pragma unroll
    for (int i = 0; i < PER; ++i) v[i] = lv[i0 + i + ((i0 + i) >> 5)];
    unsigned prefix = 0u;
    for (int bit = 30; bit >= 0; --bit) {
        const unsigned cand = prefix | (1u << bit); unsigned cnt = 0u;
#pragma unroll
        for (int i = 0; i < PER; ++i) cnt += (v[i] >= cand) ? 1u : 0u;
        cnt = (unsigned)wave_sum_i((int)cnt);
        LAS unsigned* rb = red + (bit & 1) * 8;
        if (lane == 0) rb[w] = cnt;
        __syncthreads();
        const unsigned tot = (rb[0] + rb[1]) + (rb[2] + rb[3]) + ((rb[4] + rb[5]) + (rb[6] + rb[7]));
        if (tot >= (unsigned)C) prefix = cand;
    }
    const unsigned thr = prefix;
    unsigned ng = 0u, ne = 0u;
#pragma unroll
    for (int i = 0; i < PER; ++i) { ng += (v[i] > thr) ? 1u : 0u; ne += (v[i] == thr) ? 1u : 0u; }
    __syncthreads();
    cg[tid] = ng; ce[tid] = ne;
    __syncthreads();
    if (w == 0) {
        unsigned a[8], b[8], sa = 0u, sb2 = 0u;
#pragma unroll
        for (int i = 0; i < 8; ++i) { a[i] = cg[lane * 8 + i]; b[i] = ce[lane * 8 + i]; sa += a[i]; sb2 += b[i]; }
        unsigned pa = sa, pb = sb2;
#pragma unroll
        for (int o = 1; o < 64; o <<= 1) { const unsigned ta = __shfl_up(pa, o), tb = __shfl_up(pb, o); if (lane >= o) { pa += ta; pb += tb; } }
        unsigned ea = pa - sa, eb = pb - sb2;
#pragma unroll
        for (int i = 0; i < 8; ++i) { cg[lane * 8 + i] = ea; ce[lane * 8 + i] = eb; ea += a[i]; eb += b[i]; }
        if (lane == 63) { cg[512] = pa; }
    }
    __syncthreads();
    unsigned gb = cg[tid], eb = ce[tid]; const unsigned k = (unsigned)C - cg[512];
    int* seli = (int*)(F.ws + WS_SELI); float* selw = (float*)(F.ws + WS_SELW); int* inv = (int*)(F.ws + WS_INV); const float* hs = (const float*)(F.ws + WS_HS); float* xs = (float*)(F.ws + WS_XS);
    const int sbase = g ? NE * CAP_P + e * CAP_S : e * CAP_P, rbase = g ? TP : 0;
#pragma unroll 1
    for (int i = 0; i < PER; ++i) { const unsigned u = lv[i0 + i + ((i0 + i) >> 5)]; const int row = rbase + i0 + i; int slot = -1;
        if (u > thr) { slot = (int)(gb + (eb < k ? eb : k)); ++gb; }
        else if (u == thr) { if (eb < k) slot = (int)(gb + eb); ++eb; }
        inv[(size_t)row * NE + e] = slot;
        if (slot >= 0) { seli[sbase + slot] = row; selw[sbase + slot] = __uint_as_float(u); xs[sbase + slot] = hs[row]; } }
    __syncthreads();
}
__device__ __forceinline__ void topk_task(const Frame& F, int task) {
    const int g = task >> 4, e = task & 15;
    if (g) topk_body<TS / 512>(F, 1, e); else topk_body<TP / 512>(F, 0, e);
}

__global__ void __launch_bounds__(NWAVES * 64, 2) fwd_kernel(Args args) {
    extern __shared__ __attribute__((aligned(16))) unsigned char lds[];
    Frame F;
    F.lds = (LAS unsigned char*)lds;
    F.tid = threadIdx.x; F.lane = F.tid & 63; F.wave = __builtin_amdgcn_readfirstlane(F.tid >> 6);
    F.G = gridDim.x; { const int bx = blockIdx.x; F.vcu = (F.G % 8 == 0) ? (bx % 8) * (F.G / 8) + bx / 8 : bx; }
    F.in = args.in; F.out = args.out; F.ws = args.ws;
    volatile LAS unsigned* MISC = (volatile LAS unsigned*)(F.lds + MISC_OFF);
    if (F.tid < 64) MISC[F.tid] = 0u;
    __syncthreads();
    unsigned* ctl = (unsigned*)(F.ws + WS_CTL);
    XcdBarrier bar; bar.bar = ctl + CW_BAR; bar.x = 0; bar.st = nullptr; bar.wave = F.wave;
    if (!MK_PER_PHASE) bar = xcd_barrier_post(ctl + CW_BAR, MISC + 8);
    const int lo = args.ph_lo, hi = args.ph_hi;
#define IN(k) (lo <= (k) && (k) < hi)
#define REPS(k) (((PROBE_MASK >> (k)) & 1) ? 2 : 1)
#define SEAM(k) do { if (IN(k) && IN((k) + 1)) xcd_barrier(bar); } while (0)
    const int gw = F.vcu * NWAVES + F.wave, NGW = F.G * NWAVES;
    unsigned char* const ws = F.ws; unsigned char* const ob = (unsigned char*)F.out;

    if (IN(0)) { for (int rep = 0; rep < REPS(0); ++rep) p0_prologue(F); } SEAM(0);
    F.lane = fresh_lane(); F.tid = F.lane + (F.wave << 6);
    if (IN(1)) { for (int rep = 0; rep < REPS(1); ++rep) p1_rows(F); } SEAM(1);
    if (IN(2)) {
        SchedGrid S{(const char*)(ws + WS_H1Q), (const char*)(ws + WS_WIN8), (size_t)256 * D, M / 256, IN_W / 256, F.G, (int)blockIdx.x};
        EpiGate E{(bf16_t*)(ws + WS_Q), (bf16_t*)(ob + DO_K), (bf16_t*)(ob + DO_V), (bf16_t*)(ws + WS_U), (bf16_t*)(ws + WS_VG), (bf16_t*)(ws + WS_GS), (bf16_t*)(ws + WS_GS + (size_t)M * D), (float*)(ob + DO_VST), (const float*)(ws + WS_HS1), (const float*)(ws + WS_SWIN), F.in[9], F.in[10], (LAS float*)(F.lds + AUX_OFF)};
        pg8::gemm_phase<EpiGate, SchedGrid, true, true, 1>(F.lds + RING_OFF, D, D, D / 128, S, E, F.wave);
    } SEAM(2);
    F.lane = fresh_lane(); F.tid = F.lane + (F.wave << 6);
    if (IN(3)) {
        for (int n = F.vcu; n < (M / 128) * 4; n += F.G) sgu_unit(F, n >> 2, n & 3);
        if (F.tid < 128) ((LAS float*)(F.lds + AT_GQK))[F.tid] = F.in[9][F.tid] * F.in[10][F.tid];
        __syncthreads();
        for (int n = F.vcu; n < (M / 64) * 4; n += F.G) attn_unit(F, n >> 2, n & 3);
    } SEAM(3);
    if (IN(4)) {
        { SchedGrid S{(const char*)(ws + WS_ATT8), (const char*)(ws + WS_WOA8), (size_t)256 * D, M / 256, D / 256, F.G, (int)blockIdx.x};
          EpiMerge E{(bf16_t*)(ws + WS_GA), ws + WS_GS, (const float*)(ws + WS_WSCO), 0};
          pg8::gemm_phase<EpiMerge, SchedGrid, true, true, 2>(F.lds + RING_OFF, D, D, D / 128, S, E, F.wave); }
        { SchedGrid S{(const char*)(ws + WS_U), (const char*)(ws + WS_WOS), (size_t)256 * D * 2, M / 256, D / 256, F.G, (int)blockIdx.x};
          EpiMerge E{(bf16_t*)(ws + WS_GA), ws + WS_GS + (size_t)M * D, (const float*)(ws + WS_WSCO), 1};
          pg8::gemm_phase<EpiMerge, SchedGrid, true, true>(F.lds + RING_OFF, D * 2, D * 2, D / 64, S, E, F.wave); }
    } SEAM(4);
    F.lane = fresh_lane(); F.tid = F.lane + (F.wave << 6);
    if (IN(5)) {
        const bf16* mg = (const bf16*)(ws + WS_GA); unsigned* mq = (unsigned*)(ws + WS_MQ); float* msc = (float*)(ws + WS_MS);
        for (int m = gw; m < M; m += NGW) { const v4u* src = (const v4u*)(mg + (size_t)m * D) + F.lane; v4u x[4]; float amax = 0.f;
#pragma unroll
            for (int j = 0; j < 4; ++j) { x[j] = src[64 * j];
                amax = fmaxf(amax, fmaxf(fmaxf(fmaxf(fabsf(bf_lo(x[j].x)), fabsf(bf_hi(x[j].x))), fmaxf(fabsf(bf_lo(x[j].y)), fabsf(bf_hi(x[j].y)))), fmaxf(fmaxf(fabsf(bf_lo(x[j].z)), fabsf(bf_hi(x[j].z))), fmaxf(fabsf(bf_lo(x[j].w)), fabsf(bf_hi(x[j].w)))))); }
            amax = wave_max(amax); const float inv = amax > 0.f ? 127.0f / amax : 0.f; v2u* dst = (v2u*)(mq + (size_t)m * (D / 4)) + F.lane;
#pragma unroll
            for (int j = 0; j < 4; ++j) { v2u o; o.x = q8x4(bf_lo(x[j].x), bf_hi(x[j].x), bf_lo(x[j].y), bf_hi(x[j].y), inv); o.y = q8x4(bf_lo(x[j].z), bf_hi(x[j].z), bf_lo(x[j].w), bf_hi(x[j].w), inv); dst[64 * j] = o; }
            if (F.lane == 0) msc[m] = amax * (1.0f / 127.0f); }
        if (!MK_PER_PHASE) xcd_barrier(bar);
    }
    if (IN(5)) {
        SchedGrid S{(const char*)(ws + WS_MQ), (const char*)(ws + WS_WOUT), (size_t)256 * D, M / 256, D / 256, F.G, (int)blockIdx.x};
        EpiOut E{F.in[0], F.in[1], F.out, (const float*)(ws + WS_MOD), (const float*)(ws + WS_MS), (const float*)(ws + WS_SWO)};
        pg8::gemm_phase<EpiOut, SchedGrid, true, true, 1>(F.lds + RING_OFF, D, D, D / 128, S, E, F.wave);
    } SEAM(5);
    F.lane = fresh_lane(); F.tid = F.lane + (F.wave << 6);
    if (IN(6)) { for (int rep = 0; rep < REPS(6); ++rep) p6_rows(F); } SEAM(6);
    F.lane = fresh_lane(); F.tid = F.lane + (F.wave << 6);
    if (IN(7)) for (int rep = 0; rep < REPS(7); ++rep) { for (int task = blockIdx.x; task < 2 * NE; task += F.G) topk_task(F, task); } SEAM(7);
    if (IN(9)) {
        SchedMoe S{(const char*)(ws + WS_Q), (const char*)(ws + WS_WGU), (size_t)256 * D, (size_t)256 * D, FF / 128, F.G, (int)blockIdx.x, (const int*)(ws + WS_SELI)};
        EpiGU E{ws + WS_ACT, (const float*)(ws + WS_XS), (const float*)(ws + WS_SGU)};
        pg8::gemm_phase<EpiGU, SchedMoe, true, true, 1, true>(F.lds + RING_OFF, D, D, D / 128, S, E, F.wave);
    }
    if (IN(9) && REPS(9) == 2) {
        SchedMoe S{(const char*)(ws + WS_Q), (const char*)(ws + WS_WGU), (size_t)256 * D, (size_t)256 * D, FF / 128, F.G, (int)blockIdx.x, (const int*)(ws + WS_SELI)};
        EpiGU E{ws + WS_ACT, (const float*)(ws + WS_XS), (const float*)(ws + WS_SGU)};
        pg8::gemm_phase<EpiGU, SchedMoe, true, true, 1, true>(F.lds + RING_OFF, D, D, D / 128, S, E, F.wave);
    } SEAM(9);
    if (IN(10)) {
        SchedMoe S{(const char*)(ws + WS_ACT), (const char*)(ws + WS_WD), (size_t)256 * FF, (size_t)256 * FF, D / 256, F.G, (int)blockIdx.x, nullptr};
        EpiDown E{(bf16_t*)(ws + WS_XE), (const float*)(ws + WS_SELW), (const float*)(ws + WS_WSC)};
        pg8::gemm_phase<EpiDown, SchedMoe, true, true, 2>(F.lds + RING_OFF, FF, FF, FF / 128, S, E, F.wave);
    }
    if (IN(10) && REPS(10) == 2) {
        SchedMoe S{(const char*)(ws + WS_ACT), (const char*)(ws + WS_WD), (size_t)256 * FF, (size_t)256 * FF, D / 256, F.G, (int)blockIdx.x, nullptr};
        EpiDown E{(bf16_t*)(ws + WS_XE), (const float*)(ws + WS_SELW), (const float*)(ws + WS_WSC)};
        pg8::gemm_phase<EpiDown, SchedMoe, true, true, 2>(F.lds + RING_OFF, FF, FF, FF / 128, S, E, F.wave);
    } SEAM(10);
    F.lane = fresh_lane(); F.tid = F.lane + (F.wave << 6);
    if (IN(11)) {
        const int* inv = (const int*)(ws + WS_INV); const unsigned char* Y = (const unsigned char*)(ws + WS_XE); const float* mod = (const float*)(ws + WS_MOD);
        for (int m = gw; m < M; m += NGW) {
            const int s = seq_of(m), g = m < TP ? 0 : 1; const int myinv = inv[(size_t)m * NE + (F.lane & 15)];
            f32x4* op = (f32x4*)(F.out + (size_t)m * D) + F.lane; f32x4 acc[8], xv[8];
#pragma unroll
            for (int j = 0; j < 8; ++j) { acc[j] = (f32x4){0.f, 0.f, 0.f, 0.f}; xv[j] = op[64 * j]; }
            unsigned emask = (unsigned)(__ballot(myinv >= 0) & 0xFFFFull);
            while (emask) {
                const int e1 = __ffs(emask) - 1; emask &= emask - 1; const bool two = emask != 0u; const int e2 = two ? __ffs(emask) - 1 : e1; if (two) emask &= emask - 1;
                const int c1 = __shfl(myinv, e1), c2 = __shfl(myinv, e2);
                const size_t s1 = g ? (size_t)NE * CAP_P + (size_t)e1 * CAP_S + c1 : (size_t)e1 * CAP_P + c1, s2 = g ? (size_t)NE * CAP_P + (size_t)e2 * CAP_S + c2 : (size_t)e2 * CAP_P + c2;
                const unsigned* y1p = (const unsigned*)(Y + s1 * D) + F.lane; const unsigned* y2p = (const unsigned*)(Y + s2 * D) + F.lane; unsigned y1[8], y2[8];
#pragma unroll
                for (int j = 0; j < 8; ++j) { y1[j] = __builtin_nontemporal_load(&y1p[64 * j]); y2[j] = __builtin_nontemporal_load(&y2p[64 * j]); }
#pragma unroll
                for (int j = 0; j < 8; ++j) { typedef float f2_t __attribute__((ext_vector_type(2)));
                    { const f2_t lo = __builtin_amdgcn_cvt_pk_f32_fp8((int)y1[j], false), hi = __builtin_amdgcn_cvt_pk_f32_fp8((int)y1[j], true); acc[j] += (f32x4){lo.x, lo.y, hi.x, hi.y}; }
                    if (two) { const f2_t lo = __builtin_amdgcn_cvt_pk_f32_fp8((int)y2[j], false), hi = __builtin_amdgcn_cvt_pk_f32_fp8((int)y2[j], true); acc[j] += (f32x4){lo.x, lo.y, hi.x, hi.y}; } }
            }
            const f32x4* g2 = (const f32x4*)(mod + (size_t)s * MODW + 5 * D) + F.lane;
#pragma unroll
            for (int j = 0; j < 8; ++j) __builtin_nontemporal_store(xv[j] + g2[64 * j] * (1.0f / Y_SCALE) * acc[j], &op[64 * j]);
        }
    }
#undef IN
#undef SEAM
}


__global__ void dbg_dump(const unsigned short* q, const unsigned short* u, const unsigned short* vg, const unsigned short* ga, const unsigned short* gs, float* out, size_t n) {
    for (size_t i = (size_t)blockIdx.x * blockDim.x + threadIdx.x; i < n; i += (size_t)gridDim.x * blockDim.x) {
        out[i] = __uint_as_float((unsigned)q[i] << 16) + 2.f * __uint_as_float((unsigned)u[i] << 16) + 4.f * __uint_as_float((unsigned)vg[i] << 16) + 8.f * __uint_as_float((unsigned)ga[i] << 16) + 16.f * __uint_as_float((unsigned)gs[i] << 16); }
}

__global__ void dbg_dump2(const unsigned short* win, const unsigned short* wgu, const unsigned short* wd, const unsigned short* woa, float* out, size_t n) {
    for (size_t i = (size_t)blockIdx.x * blockDim.x + threadIdx.x; i < n; i += (size_t)gridDim.x * blockDim.x) {
        out[i] = __uint_as_float((unsigned)win[i % ((size_t)IN_W * D)] << 16) + 2.f * __uint_as_float((unsigned)wgu[i] << 16) + 4.f * __uint_as_float((unsigned)wd[i % ((size_t)NE * D * FF)] << 16) + 8.f * __uint_as_float((unsigned)woa[i % ((size_t)3 * D * D)] << 16); }
}

__device__ __forceinline__ float bf16r(float f) { unsigned u = __float_as_uint(f); u += 0x7fffu + ((u >> 16) & 1u); return __uint_as_float(u & 0xffff0000u); }
__global__ void dbg_check_gemm(const unsigned short* h1, const float* w_in, const unsigned short* Q, const unsigned short* Kb, const unsigned short* Vb, unsigned* cnt) {
    const int i = blockIdx.x * blockDim.x + threadIdx.x;
    unsigned long long z = (unsigned long long)i * 0x9E3779B97F4A7C15ull + 12345; z ^= z >> 29; z *= 0xBF58476D1CE4E5B9ull; z ^= z >> 32;
    const int m = (int)(z % M), n = (int)((z >> 20) % 3072);
    float ref = 0.f;
    for (int k = 0; k < D; ++k) ref += __uint_as_float((unsigned)h1[(size_t)m * D + k] << 16) * bf16r(w_in[(size_t)k * IN_W + n]);
    float got;
    if (n < 2048) got = __uint_as_float((unsigned)Q[(size_t)m * D + n] << 16);
    else if (n < 2560) got = __uint_as_float((unsigned)Kb[(size_t)m * KVW + n - 2048] << 16);
    else got = __uint_as_float((unsigned)Vb[(size_t)m * KVW + n - 2560] << 16);
    const float err = fabsf(got - ref);
    if (!(err <= 0.03f * (1.0f + fabsf(ref)))) { atomicAdd(cnt, 1u); if (n < 2048) atomicAdd(cnt + 1, 1u); else if (n < 2560) atomicAdd(cnt + 2, 1u); else atomicAdd(cnt + 3, 1u); if (fabsf(got) > 100.f) atomicAdd(cnt + 4, 1u); }
}
__global__ void dbg_fill(float* out, size_t n, const unsigned* cnt, int which) {
    const unsigned c = cnt[which]; const float v = c == 0 ? 0.f : c < 10 ? 1.f : c < 100 ? 2.f : c < 1000 ? 3.f : c < 10000 ? 4.f : 5.f;
    for (size_t i = (size_t)blockIdx.x * blockDim.x + threadIdx.x; i < n; i += (size_t)gridDim.x * blockDim.x) out[i] = v;
}
extern "C" void kernel_launch(void* const* d_in, const int* in_sizes, int n_in, void* d_out, int out_size, void* d_ws, size_t ws_size, hipStream_t stream) {
    static int grid = 0;
    if (grid == 0) {
        if (n_in != 23 || out_size != M * D || ws_size < WS_END) { fprintf(stderr, "kernel_launch: unexpected shapes (n_in %d, out %d, ws %zu, need %zu)\n", n_in, out_size, ws_size, (size_t)WS_END); grid = -1; return; }
        int dev = 0, cus = 0, per_cu = 0;
        if (hipGetDevice(&dev) != hipSuccess || hipDeviceGetAttribute(&cus, hipDeviceAttributeMultiprocessorCount, dev) != hipSuccess) { grid = -1; return; }
        if (hipFuncSetAttribute((const void*)fwd_kernel, hipFuncAttributeMaxDynamicSharedMemorySize, LDS_BYTES) != hipSuccess) { fprintf(stderr, "kernel_launch: hipFuncSetAttribute failed\n"); grid = -1; return; }
        if (hipOccupancyMaxActiveBlocksPerMultiprocessor(&per_cu, (const void*)fwd_kernel, NWAVES * 64, LDS_BYTES) != hipSuccess || per_cu < 1) fprintf(stderr, "kernel_launch: occupancy query says %d\n", per_cu);
        (void)hipGetLastError();
        grid = cus;
    }
    if (grid < 0) return;
    (void)hipMemsetAsync((char*)d_ws + WS_CTL, 0, CTL_ZERO_BYTES, stream);
    Args a{};
    for (int i = 0; i < 23; ++i) a.in[i] = (const float*)d_in[i];
    a.out = (float*)d_out; a.ws = (unsigned char*)d_ws;
#if MK_PER_PHASE
    for (int p = 0; p < DBG_NPH; ++p) { a.ph_lo = p; a.ph_hi = p + 1; a.li = p; hipLaunchKernelGGL(fwd_kernel, dim3(grid), dim3(NWAVES * 64), LDS_BYTES, stream, a); }
    if (DBG_NPH == 1) { unsigned char* w = (unsigned char*)d_ws; hipLaunchKernelGGL(dbg_dump2, dim3(4096), dim3(256), 0, stream, (const unsigned short*)(w + WS_WIN), (const unsigned short*)(w + WS_WGU), (const unsigned short*)(w + WS_WD), (const unsigned short*)(w + WS_WOA), (float*)d_out, (size_t)M * D); }
    else if (DBG_NPH == 3) { unsigned char* w = (unsigned char*)d_ws; unsigned* cnt = (unsigned*)(w + 512 * 1024);
        hipLaunchKernelGGL(dbg_check_gemm, dim3(256), dim3(256), 0, stream, (const unsigned short*)(w + WS_WGU), (const float*)d_in[8], (const unsigned short*)(w + WS_Q), (const unsigned short*)((unsigned char*)d_out + DO_K), (const unsigned short*)((unsigned char*)d_out + DO_V), cnt);
        hipLaunchKernelGGL(dbg_fill, dim3(4096), dim3(256), 0, stream, (float*)d_out, (size_t)M * D, (const unsigned*)cnt, DBG_WHICH); }
    else if (DBG_NPH < 6) { unsigned char* w = (unsigned char*)d_ws; hipLaunchKernelGGL(dbg_dump, dim3(4096), dim3(256), 0, stream, (const unsigned short*)(w + WS_Q), (const unsigned short*)(w + WS_U), (const unsigned short*)(w + WS_VG), (const unsigned short*)(w + WS_GA), (const unsigned short*)(w + WS_GS), (float*)d_out, (size_t)M * D); }
#else
    a.ph_lo = 0; a.ph_hi = NPHASE; a.li = 0; hipLaunchKernelGGL(fwd_kernel, dim3(grid), dim3(NWAVES * 64), LDS_BYTES, stream, a);
#endif
}
```

```cpp
#include <hip/hip_runtime.h>
#include <cstdio>
#include <cstdint>

#ifndef MK_PER_PHASE
#define MK_PER_PHASE 0
#endif
#ifndef PROBE_MASK
#define PROBE_MASK 0
#endif
#ifndef DBG_WHICH
#define DBG_WHICH 0
#endif
#ifndef DBG_NPH
#define DBG_NPH 12
#endif

namespace pg8 {
#define PG8_LAS __attribute__((address_space(3)))
typedef unsigned short bf16_t;
typedef short bf16x8 __attribute__((ext_vector_type(8)));
typedef float f32x4 __attribute__((ext_vector_type(4)));
typedef unsigned u32x4 __attribute__((ext_vector_type(4)));
constexpr int BM = 256, BK = 64, HALF = 128, HTB = HALF * BK * 2, STAGE_BYTES = 8 * HTB, NXCD = 8, WGM = 4;

__host__ __device__ __forceinline__ int lds_byte(int r, int c) { const int st = (r >> 4) * 2 + (c >> 5), rr = r & 15, cc = c & 31, ob = rr * 64 + cc * 2; return st * 1024 + (ob ^ (((ob >> 9) & 1) << 5)); }
__host__ __device__ __forceinline__ void stage_rc(int b, int& R, int& C) { const int st = b / 1024, sb = b % 1024, swz = sb ^ (((sb >> 9) & 1) << 5); R = (st >> 1) * 16 + swz / 64; C = (st & 1) * 32 + (swz % 64) / 2; }
__host__ __device__ __forceinline__ int perm32(int rho) { const int n = rho >> 4, i = rho & 15; return 8 * (i >> 2) + 4 * n + (i & 3); }

struct Unit { const char* a; const char* b; const int* idx; int pm, pn, aux; };

__device__ __forceinline__ void tile_of(int wgid, int nM, int nN, int& pm, int& pn) {
    const int nwg = nM * nN; { const int q = nwg / NXCD, r = nwg % NXCD, xcd = wgid % NXCD, off = wgid / NXCD; wgid = (xcd < r ? xcd * (q + 1) : r * (q + 1) + (xcd - r) * q) + off; }
    const int nig = WGM * nN, gid = wgid / nig, fm = gid * WGM, gsz = (nM - fm) < WGM ? (nM - fm) : WGM;
    pm = fm + ((wgid % nig) % gsz); pn = (wgid % nig) / gsz;
}

__device__ __forceinline__ unsigned cvt_pk_bf16(float lo, float hi) { unsigned r; asm volatile("s_nop 1\n\tv_cvt_pk_bf16_f32 %0, %1, %2" : "=v"(r) : "v"(lo), "v"(hi)); return r; }
__device__ __forceinline__ float bf_lo(unsigned u) { return __uint_as_float(u << 16); }
__device__ __forceinline__ float bf_hi(unsigned u) { return __uint_as_float(u & 0xffff0000u); }

typedef int i32x4 __attribute__((ext_vector_type(4)));
typedef int i32x8 __attribute__((ext_vector_type(8)));
template <int MODE> struct AccT { typedef f32x4 type; };
template <> struct AccT<1> { typedef i32x4 type; };
template <class Epi, class Sched, bool ALIGN_EPI = false, bool SP2 = false, int MODE = 0, bool GATHER = false>
__device__ __forceinline__ void gemm_phase(PG8_LAS unsigned char* lds, const int PA, const int PB, const int nt, const Sched& S, const Epi& E, const int wid_in) {
    const int tid = threadIdx.x, wid = __builtin_amdgcn_readfirstlane(tid >> 6), lane = tid & 63, wr = wid >> 2, wc = wid & 3, fr = lane & 15, fq = lane >> 4;
    typedef typename AccT<MODE>::type acc_t;
    unsigned voffA[2], voffB[2];
#pragma unroll
    for (int i = 0; i < 2; ++i) { int R, C; stage_rc(tid * 16 + i * 8192, R, C); const int Rb = (R & ~31) + perm32(R & 31);
        voffA[i] = (unsigned)(R * PA + C * 2); voffB[i] = (unsigned)(Rb * PB + C * 2); }
    unsigned vgC[2][2], vgN[2][2]; int gR[2], gC2[2];
    if constexpr (GATHER) { static_assert(SP2, "GATHER is written for the SP2 loop");
#pragma unroll
        for (int i = 0; i < 2; ++i) { int R, C; stage_rc(tid * 16 + i * 8192, R, C); gR[i] = R; gC2[i] = C * 2; } }
    PG8_LAS unsigned char* idxbuf = lds + 131072 + 4096;
#define PG8_IDX_DMA(ptr, slot) do { if (wid == 0) __builtin_amdgcn_global_load_lds((const unsigned*)((const char*)(ptr) + lane * 16), (PG8_LAS unsigned*)(idxbuf + (slot) * 1024), 16, 0, 0); } while (0)
#define PG8_IDX_READ(dst, slot) do { _Pragma("unroll") for (int h_ = 0; h_ < 2; ++h_) _Pragma("unroll") for (int i_ = 0; i_ < 2; ++i_) \
        dst[h_][i_] = (unsigned)(*(const PG8_LAS int*)(idxbuf + (slot) * 1024 + (h_ * 128 + gR[i_]) * 4)) * (unsigned)PA + (unsigned)gC2[i_]; } while (0)
    const size_t kstep = (size_t)(BK * 2);
    const size_t hstepA = (size_t)HALF * PA, hstepB = (size_t)HALF * PB;
    const unsigned ldsw = (unsigned)wid * 1024u;
    const int aoff = lds_byte(wr * 64 + fr, fq * 8), boff = lds_byte(wc * 32 + fr, fq * 8);
#define PG8_SA(b, h) (((b) * 2 + (h)) * HTB)
#define PG8_SB(b, h) ((4 + (b) * 2 + (h)) * HTB)
#define PG8_STAGE(bufoff, gbase, voff) do { _Pragma("unroll") for (int _i = 0; _i < 2; ++_i) \
        __builtin_amdgcn_global_load_lds((const unsigned*)((const char*)(gbase) + (voff)[_i]), (PG8_LAS unsigned*)(lds + (bufoff) + ldsw + _i * 8192), 16, 0, 0); } while (0)
#define PG8_STAGE_A(b, h, kptr, NXT) do { if constexpr (GATHER) { _Pragma("unroll") for (int _i = 0; _i < 2; ++_i) { const unsigned vo_ = (NXT) ? vgN[h][_i] : vgC[h][_i]; \
        __builtin_amdgcn_global_load_lds((const unsigned*)((const char*)(kptr) + vo_), (PG8_LAS unsigned*)(lds + PG8_SA(b, h) + ldsw + _i * 8192), 16, 0, 0); } } \
        else PG8_STAGE(PG8_SA(b, h), (kptr) + (h) * hstepA, voffA); } while (0)
#define PG8_LDA(dst, b, h) do { _Pragma("unroll") for (int m = 0; m < 4; ++m) { if constexpr (MODE == 2) { const i32x4 lo_ = *(const PG8_LAS i32x4*)(lds + PG8_SA(b, h) + aoff + m * 2048), hi_ = *(const PG8_LAS i32x4*)(lds + PG8_SA(b, h) + aoff + m * 2048 + 1024); \
            dst##8[m] = __builtin_shufflevector(lo_, hi_, 0, 1, 2, 3, 4, 5, 6, 7); } else { _Pragma("unroll") for (int k = 0; k < 2; ++k) dst[m][k] = *(const PG8_LAS bf16x8*)(lds + PG8_SA(b, h) + aoff + m * 2048 + k * 1024); } } } while (0)
#define PG8_LDB(dst, b, h) do { _Pragma("unroll") for (int n = 0; n < 2; ++n) { if constexpr (MODE == 2) { const i32x4 lo_ = *(const PG8_LAS i32x4*)(lds + PG8_SB(b, h) + boff + n * 2048), hi_ = *(const PG8_LAS i32x4*)(lds + PG8_SB(b, h) + boff + n * 2048 + 1024); \
            dst##8[n] = __builtin_shufflevector(lo_, hi_, 0, 1, 2, 3, 4, 5, 6, 7); } else { _Pragma("unroll") for (int k = 0; k < 2; ++k) dst[n][k] = *(const PG8_LAS bf16x8*)(lds + PG8_SB(b, h) + boff + n * 2048 + k * 1024); } } } while (0)
#define PG8_MMA(ai, bj, At, Bt) do { __builtin_amdgcn_s_setprio(1); _Pragma("unroll") for (int m = 0; m < 4; ++m) _Pragma("unroll") for (int n = 0; n < 2; ++n) { \
        if constexpr (MODE == 2) { asm volatile("v_mfma_scale_f32_16x16x128_f8f6f4 %0, %1, %2, %0, %3, %3 op_sel_hi:[0,0,0]" : "+v"(acc[ai][bj][m][n]) : "v"(Bt##8[n]), "v"(At##8[m]), "v"(sc127)); } \
        else { _Pragma("unroll") for (int k = 0; k < 2; ++k) { \
          if constexpr (MODE == 1) acc[ai][bj][m][n] = __builtin_amdgcn_mfma_i32_16x16x64_i8(__builtin_bit_cast(i32x4, Bt[n][k]), __builtin_bit_cast(i32x4, At[m][k]), acc[ai][bj][m][n], 0, 0, 0); \
          else acc[ai][bj][m][n] = __builtin_amdgcn_mfma_f32_16x16x32_bf16(Bt[n][k], At[m][k], acc[ai][bj][m][n], 0, 0, 0); } } } __builtin_amdgcn_s_setprio(0); } while (0)
#define PG8_WAIT_V(n) asm volatile("s_waitcnt vmcnt(" #n ")" ::: "memory")
#define PG8_WAIT_L(n) asm volatile("s_waitcnt lgkmcnt(" #n ")" ::: "memory")
#define PG8_BAR __builtin_amdgcn_s_barrier()
#define PG8_SCHED __builtin_amdgcn_sched_barrier(0)
    Unit cur, nxt; int ui = 0;
    if (!S.next(0, cur)) return;
    acc_t acc[2][2][4][2];
#pragma unroll
    for (int a = 0; a < 2; ++a)
#pragma unroll
        for (int b = 0; b < 2; ++b)
#pragma unroll
            for (int m = 0; m < 4; ++m)
#pragma unroll
                for (int n = 0; n < 2; ++n) acc[a][b][m][n] = (acc_t){0, 0, 0, 0};
    const int sc127 = 0x7F7F7F7F;
    bf16x8 At[4][2], B0[2][2], B1[2][2]; i32x8 At8[4], B08[2], B18[2];
    const char* cA = cur.a; const char* cB = cur.b;
    if constexpr (SP2) {
        if constexpr (GATHER) { PG8_IDX_DMA(cur.idx, 0); PG8_WAIT_V(0); __syncthreads(); PG8_IDX_READ(vgC, 0); PG8_WAIT_L(0);
#pragma unroll
            for (int h_ = 0; h_ < 2; ++h_) { vgN[h_][0] = vgC[h_][0]; vgN[h_][1] = vgC[h_][1]; } }
        PG8_STAGE(PG8_SB(0, 0), cB, voffB); PG8_STAGE(PG8_SB(0, 1), cB + hstepB, voffB); PG8_STAGE_A(0, 0, cA, false); PG8_STAGE_A(0, 1, cA, false);
        if (wr == 1) PG8_BAR;
        PG8_WAIT_V(2); PG8_BAR;
        PG8_STAGE(PG8_SB(1, 0), cB + kstep, voffB); PG8_STAGE_A(1, 0, cA + kstep, false); PG8_STAGE(PG8_SB(1, 1), cB + hstepB + kstep, voffB);
        PG8_WAIT_V(6); PG8_BAR;
    } else {
        PG8_STAGE(PG8_SB(0, 0), cB, voffB); PG8_STAGE(PG8_SA(0, 0), cA, voffA); PG8_STAGE(PG8_SB(0, 1), cB + hstepB, voffB); PG8_STAGE(PG8_SA(0, 1), cA + hstepA, voffA);
        if (wr == 1) PG8_BAR;
        PG8_WAIT_V(4); PG8_BAR;
        PG8_STAGE(PG8_SB(1, 0), cB + kstep, voffB); PG8_STAGE(PG8_SA(1, 0), cA + kstep, voffA); PG8_STAGE(PG8_SB(1, 1), cB + hstepB + kstep, voffB);
        PG8_WAIT_V(6); PG8_BAR;
    }
    for (;;) {
        const bool has_next = S.next(ui + 1, nxt);
        const char* nA = has_next ? nxt.a : cA; const char* nB = has_next ? nxt.b : cB;
        if constexpr (GATHER) { if (has_next) PG8_IDX_DMA(nxt.idx, (ui + 1) & 1); }
        for (int t = 0; t < nt; t += 2) {
            const bool last = (t == nt - 2);
            const char* a1 = cA + (size_t)(t + 1) * kstep;
            const char* a2 = last ? nA : cA + (size_t)(t + 2) * kstep; const char* b2 = last ? nB : cB + (size_t)(t + 2) * kstep;
            const char* a3 = a2 + kstep; const char* b3 = b2 + kstep;
            if constexpr (SP2) {
            if constexpr (GATHER) { if (t == 4 && has_next) PG8_IDX_READ(vgN, (ui + 1) & 1); }
            PG8_LDB(B0, 0, 0); PG8_LDB(B1, 0, 1); PG8_SCHED; PG8_LDA(At, 0, 0); PG8_STAGE_A(1, 1, a1, false);
            PG8_WAIT_V(8); PG8_WAIT_L(0); PG8_BAR; PG8_MMA(0, 0, At, B0); PG8_MMA(0, 1, At, B1); PG8_BAR; PG8_SCHED;
            PG8_LDA(At, 0, 1); PG8_STAGE(PG8_SB(0, 0), b2, voffB); PG8_STAGE(PG8_SB(0, 1), b2 + hstepB, voffB); PG8_STAGE_A(0, 0, a2, last);
            PG8_WAIT_V(8); PG8_WAIT_L(0); PG8_BAR; PG8_MMA(1, 0, At, B0); PG8_MMA(1, 1, At, B1); PG8_BAR; PG8_SCHED;
            PG8_LDB(B0, 1, 0); PG8_LDB(B1, 1, 1); PG8_SCHED; PG8_LDA(At, 1, 0); PG8_STAGE_A(0, 1, a2, last);
            PG8_WAIT_V(8); PG8_WAIT_L(0); PG8_BAR; PG8_MMA(0, 0, At, B0); PG8_MMA(0, 1, At, B1); PG8_BAR; PG8_SCHED;
            PG8_LDA(At, 1, 1); PG8_STAGE(PG8_SB(1, 0), b3, voffB); PG8_STAGE(PG8_SB(1, 1), b3 + hstepB, voffB); PG8_STAGE_A(1, 0, a3, last);
            PG8_WAIT_V(8); PG8_WAIT_L(0); PG8_BAR; PG8_MMA(1, 0, At, B0); PG8_MMA(1, 1, At, B1); PG8_BAR; PG8_SCHED;
            } else {
            PG8_LDB(B0, 0, 0); PG8_SCHED; PG8_LDA(At, 0, 0); PG8_STAGE(PG8_SA(1, 1), a1 + hstepA, voffA);
            PG8_WAIT_L(8); PG8_BAR; PG8_WAIT_L(0); PG8_MMA(0, 0, At, B0); PG8_BAR; PG8_SCHED;
            PG8_LDB(B1, 0, 1); PG8_STAGE(PG8_SB(0, 0), b2, voffB);
            PG8_BAR; PG8_WAIT_L(0); PG8_MMA(0, 1, At, B1); PG8_BAR;
            PG8_LDA(At, 0, 1); PG8_STAGE(PG8_SA(0, 0), a2, voffA);
            PG8_BAR; PG8_WAIT_L(0); PG8_MMA(1, 0, At, B0); PG8_BAR; PG8_SCHED;
            PG8_STAGE(PG8_SB(0, 1), b2 + hstepB, voffB);
            PG8_WAIT_V(6); PG8_BAR; PG8_MMA(1, 1, At, B1); PG8_BAR;
            PG8_LDB(B0, 1, 0); PG8_SCHED; PG8_LDA(At, 1, 0); PG8_STAGE(PG8_SA(0, 1), a2 + hstepA, voffA);
            PG8_WAIT_L(8); PG8_BAR; PG8_WAIT_L(0); PG8_MMA(0, 0, At, B0); PG8_BAR; PG8_SCHED;
            PG8_LDB(B1, 1, 1); PG8_STAGE(PG8_SB(1, 0), b3, voffB);
            PG8_BAR; PG8_WAIT_L(0); PG8_MMA(0, 1, At, B1); PG8_BAR;
            PG8_LDA(At, 1, 1); PG8_STAGE(PG8_SA(1, 0), a3, voffA);
            PG8_BAR; PG8_WAIT_L(0); PG8_MMA(1, 0, At, B0); PG8_BAR; PG8_SCHED;
            PG8_STAGE(PG8_SB(1, 1), b3 + hstepB, voffB);
            PG8_WAIT_V(6); PG8_BAR; PG8_MMA(1, 1, At, B1); PG8_BAR;
            }
        }
        if constexpr (ALIGN_EPI) { if (wr == 0) PG8_BAR; }
        E(acc, cur, wr, wc, fr, fq);
        if (!has_next) break;
#pragma unroll
        for (int a = 0; a < 2; ++a)
#pragma unroll
            for (int b = 0; b < 2; ++b)
#pragma unroll
                for (int m = 0; m < 4; ++m)
#pragma unroll
                    for (int n = 0; n < 2; ++n) acc[a][b][m][n] = (acc_t){0, 0, 0, 0};
        cur = nxt; cA = nA; cB = nB; ++ui;
        if constexpr (GATHER) {
#pragma unroll
            for (int h_ = 0; h_ < 2; ++h_) { vgC[h_][0] = vgN[h_][0]; vgC[h_][1] = vgN[h_][1]; } }
        if constexpr (ALIGN_EPI) { if (wr == 1) PG8_BAR; }
    }
    PG8_WAIT_V(0);
    if constexpr (!ALIGN_EPI) { if (wr == 0) PG8_BAR; }
    PG8_BAR;
#undef PG8_SA
#undef PG8_SB
#undef PG8_STAGE
#undef PG8_STAGE_A
#undef PG8_IDX_DMA
#undef PG8_IDX_READ
#undef PG8_LDA
#undef PG8_LDB
#undef PG8_MMA
#undef PG8_WAIT_V
#undef PG8_WAIT_L
#undef PG8_BAR
#undef PG8_SCHED
}
}

constexpr int D = 2048, TP = 16384, TS = 32768, M = TP + TS, NSEQ = 6;
constexpr int IN_W = 11264, KVW = 512, NE = 16, FF = 2816, CAP_P = TP / 8, CAP_S = TS / 8, NSLOT = NE * (CAP_P + CAP_S);
constexpr int MODW = 6 * D, ADA_KC = 8;
constexpr float NORM_EPS = 1e-6f;
constexpr int NWAVES = 8, NPHASE = 12;

constexpr size_t MiB = 1u << 20;
constexpr size_t WS_CTL = 0, CTL_ZERO_BYTES = 1 * MiB;
constexpr size_t WS_MODP = 1 * MiB;
constexpr size_t WS_MOD = 3 * MiB + 512 * 1024;
constexpr size_t WS_WIN = 4 * MiB;
constexpr size_t WS_VS = 4 * MiB, WS_US = 6 * MiB;
constexpr size_t WS_WOA = 48 * MiB, WS_WOS = 56 * MiB, WS_WOUT = 64 * MiB;
constexpr size_t WS_WGU = 72 * MiB;
constexpr size_t WS_WD = 424 * MiB;
constexpr size_t WS_AFF = 600 * MiB;
constexpr size_t WS_AFFT = 603 * MiB;
constexpr size_t WS_INV = 606 * MiB;
constexpr size_t WS_SELI = 609 * MiB;
constexpr size_t WS_SELW = 609 * MiB + 512 * 1024;
constexpr size_t WS_U_FWD = 612 * MiB;
constexpr size_t WS_SGW = 610 * MiB;
constexpr size_t WS_SGU = 610 * MiB + 512 * 1024;
constexpr size_t WS_HS = 611 * MiB;
constexpr size_t WS_XS = 611 * MiB + 256 * 1024;
constexpr size_t WS_WDT = WS_U_FWD + 352 * MiB;
constexpr size_t WS_EMAX = 64 * 1024;
constexpr size_t WS_WSC = 611 * MiB + 640 * 1024;
constexpr size_t WS_H1Q = WS_WGU + 176 * MiB;
constexpr size_t WS_WIN8 = WS_WGU + 272 * MiB;
constexpr size_t WS_ATT8 = WS_H1Q;
constexpr size_t WS_WOA8 = WS_WIN8 + 24 * MiB;
constexpr size_t WS_OMAX = 64 * 1024 + 256;
constexpr size_t WS_WSCO = 610 * MiB + 960 * 1024;
constexpr size_t WS_MQ = WS_H1Q;
constexpr size_t WS_MS = WS_XS;
constexpr size_t WS_SWO = 610 * MiB + 976 * 1024;
constexpr size_t WS_HS1 = WS_XS;
constexpr size_t WS_SWIN = 610 * MiB + 896 * 1024;
constexpr size_t WS_CMAXIN = 512 * 1024 + 64 * 1024;
constexpr size_t WS_CMAX = 128 * 1024;
constexpr int NGUROWS = NE * 22 * 256;
constexpr size_t WS_VG8 = 804 * MiB, WS_U8 = 900 * MiB;
constexpr size_t WS_U = 612 * MiB, WS_VG = 804 * MiB, WS_Q = 996 * MiB, WS_GA = 1188 * MiB, WS_GS = 1380 * MiB, WS_END = 1572 * MiB;
constexpr size_t WS_XE = WS_Q;
constexpr size_t WS_GUT = WS_U;
constexpr size_t WS_ACT = WS_U;
constexpr size_t DO_H1 = 0, DO_K = 192 * MiB, DO_V = 240 * MiB, DO_VST = 288 * MiB;
constexpr int CW_TMO = 0, CW_BAR = 4096;

constexpr int RING_OFF = 0, RING_BYTES = 131072, AUX_OFF = 131072, AUX_BYTES = 16384, MISC_OFF = AUX_OFF + AUX_BYTES, LDS_BYTES = MISC_OFF + 256;

#define GAS __attribute__((address_space(1)))
#define LAS __attribute__((address_space(3)))
typedef unsigned short bf16;
typedef unsigned v4u __attribute__((ext_vector_type(4)));
typedef unsigned v2u __attribute__((ext_vector_type(2)));
typedef float f32x4 __attribute__((ext_vector_type(4)));
typedef GAS unsigned gu32;
#define RLX_AGENT __ATOMIC_RELAXED, __HIP_MEMORY_SCOPE_AGENT
#define LDS_WAIT() asm volatile("s_waitcnt lgkmcnt(0)" ::: "memory")
#define VM_WAIT() asm volatile("s_waitcnt vmcnt(0)" ::: "memory")
using pg8::cvt_pk_bf16; using pg8::bf_lo; using pg8::bf_hi;

#define XB_TMO      128
#define XB_XCNT(j)  (256  + 64 * (j))
#define XB_XSUB(j)  (1280 + 64 * (j))
#define XB_XGEN(j)  (2304 + 64 * (j))
#define XB_TOP      3328
#define XB_TOPGEN   3392
#define XCD_BAR_WORDS 3456
#define XB_SPIN_CAP (1u << 22)
__device__ __forceinline__ unsigned xb_ld(unsigned* p)              { return __hip_atomic_load(p, __ATOMIC_RELAXED, __HIP_MEMORY_SCOPE_AGENT); }
__device__ __forceinline__ unsigned xb_add(unsigned* p, unsigned v) { return __hip_atomic_fetch_add(p, v, __ATOMIC_RELAXED, __HIP_MEMORY_SCOPE_AGENT); }
__device__ __forceinline__ unsigned xb_xcc_id() { return (unsigned)__builtin_amdgcn_s_getreg((3 << 11) | 20) & 0xFu; }
#define XB_SPIN(cond, bar) do { unsigned _sp = 0; while (cond) { __builtin_amdgcn_s_sleep(1); \
    if ((++_sp & 255u) == 0u) { if (xb_ld(&(bar)[XB_TMO])) break; if (_sp > XB_SPIN_CAP) { atomicAdd(&(bar)[XB_TMO], 1u); break; } } } } while (0)
struct XcdBarrier { unsigned* bar; unsigned x; volatile LAS unsigned* st; int wave; };
__device__ __forceinline__ XcdBarrier xcd_barrier_post(unsigned* bar, volatile LAS unsigned* st) {
    XcdBarrier b; b.bar = bar; b.x = xb_xcc_id(); b.st = st; b.wave = __builtin_amdgcn_readfirstlane((int)threadIdx.x >> 6);
    if (threadIdx.x == 0) (void)xb_add(&bar[XB_XCNT(b.x)], 1u);
    return b;
}
__device__ __forceinline__ void xcd_barrier_complete(unsigned* bar, unsigned x, unsigned& nloc, unsigned& nx) {
    const unsigned G = gridDim.x * gridDim.y * gridDim.z;
    unsigned sum, cnt, mine, sp = 0u;
    for (;;) {
        sum = 0u; cnt = 0u; mine = 0u;
#pragma unroll
        for (unsigned j = 0; j < 16; ++j) { const unsigned c = xb_ld(&bar[XB_XCNT(j)]); sum += c; cnt += (c > 0u) ? 1u : 0u; mine = (j == x) ? c : mine; }
        if (sum == G) break;
        __builtin_amdgcn_s_sleep(1);
        if ((++sp & 255u) == 0u) { if (xb_ld(&bar[XB_TMO])) break; if (sp > XB_SPIN_CAP) { atomicAdd(&bar[XB_TMO], 1u); break; } }
    }
    nloc = mine > 0u ? mine : 1u; nx = cnt > 0u ? cnt : 1u;
}
__device__ __forceinline__ void xcd_barrier(const XcdBarrier& b) {
    asm volatile("s_waitcnt vmcnt(0)" ::: "memory");
    __syncthreads();
    int l0_; asm volatile("v_mbcnt_lo_u32_b32 %0, -1, 0\n\tv_mbcnt_hi_u32_b32 %0, -1, %0" : "=v"(l0_));
    if (b.wave == 0 && l0_ == 0) {
        unsigned* bar = b.bar;
        __builtin_amdgcn_s_waitcnt(0);
        unsigned nloc = b.st[0], nx = b.st[1];
        if (nloc == 0u) { xcd_barrier_complete(bar, b.x, nloc, nx); b.st[0] = nloc; b.st[1] = nx; }
        const unsigned old = xb_add(&bar[XB_XSUB(b.x)], 1u);
        const unsigned gen = old / nloc;
        if (old + 1u == (gen + 1u) * nloc) {
            __builtin_amdgcn_fence(__ATOMIC_RELEASE, "agent");
            asm volatile("s_waitcnt vmcnt(0)" ::: "memory");
            const unsigned og = xb_add(&bar[XB_TOP], 1u);
            const unsigned tg = og / nx;
            if (og + 1u == (tg + 1u) * nx) xb_add(&bar[XB_TOPGEN], 1u);
            else XB_SPIN(xb_ld(&bar[XB_TOPGEN]) == tg, bar);
            __builtin_amdgcn_fence(__ATOMIC_ACQUIRE, "agent");
            xb_add(&bar[XB_XGEN(b.x)], 1u);
            asm volatile("s_waitcnt vmcnt(0)" ::: "memory");
        } else {
            XB_SPIN(xb_ld(&bar[XB_XGEN(b.x)]) == gen, bar);
            __builtin_amdgcn_fence(__ATOMIC_ACQUIRE, "agent");
            asm volatile("s_waitcnt vmcnt(0)" ::: "memory");
        }
    }
    __syncthreads();
}

struct Args { const float* in[23]; float* out; unsigned char* ws; int ph_lo, ph_hi, li, pad; };
struct Frame {
    LAS unsigned char* lds;
    int tid, lane, wave, vcu, G;
    const float* const* in;
    float* out; unsigned char* ws;
};
__device__ __forceinline__ int fresh_lane() { int l; asm volatile("v_mbcnt_lo_u32_b32 %0, -1, 0\n\tv_mbcnt_hi_u32_b32 %0, -1, %0" : "=v"(l)); return l; }
template <int CTRL> __device__ __forceinline__ float dpp_mov(float v) { return __int_as_float(__builtin_amdgcn_update_dpp(0, __float_as_int(v), CTRL, 0xF, 0xF, true)); }
__device__ __forceinline__ float lane_bcast(float v, int l) { return __int_as_float(__builtin_amdgcn_readlane(__float_as_int(v), l)); }
__device__ __forceinline__ float wave_sum(float v) {
    v += dpp_mov<0xB1>(v); v += dpp_mov<0x4E>(v); v += dpp_mov<0x141>(v); v += dpp_mov<0x140>(v);
    return (lane_bcast(v, 0) + lane_bcast(v, 16)) + (lane_bcast(v, 32) + lane_bcast(v, 48));
}
__device__ __forceinline__ int wave_sum_i(int v) {
    v += __builtin_amdgcn_update_dpp(0, v, 0xB1, 0xF, 0xF, true); v += __builtin_amdgcn_update_dpp(0, v, 0x4E, 0xF, 0xF, true); v += __builtin_amdgcn_update_dpp(0, v, 0x141, 0xF, 0xF, true); v += __builtin_amdgcn_update_dpp(0, v, 0x140, 0xF, 0xF, true);
    return (__builtin_amdgcn_readlane(v, 0) + __builtin_amdgcn_readlane(v, 16)) + (__builtin_amdgcn_readlane(v, 32) + __builtin_amdgcn_readlane(v, 48));
}
__device__ __forceinline__ float wave_max(float v) {
    v = fmaxf(v, dpp_mov<0xB1>(v)); v = fmaxf(v, dpp_mov<0x4E>(v)); v = fmaxf(v, dpp_mov<0x141>(v)); v = fmaxf(v, dpp_mov<0x140>(v));
    return fmaxf(fmaxf(lane_bcast(v, 0), lane_bcast(v, 16)), fmaxf(lane_bcast(v, 32), lane_bcast(v, 48)));
}
__device__ __forceinline__ int seq_of(int m) { return m < TP ? (m >> 12) : 4 + ((m - TP) >> 14); }
__device__ __forceinline__ int seq_start(int s) { return s < 4 ? s * 4096 : TP + (s - 4) * 16384; }
__device__ __forceinline__ int seq_len(int s) { return s < 4 ? 4096 : 16384; }
__device__ __forceinline__ const float* xrow_ptr(const Frame& F, int m) { return m < TP ? F.in[0] + (size_t)m * D : F.in[1] + (size_t)(m - TP) * D; }

__device__ __forceinline__ void ada_item(const Frame& F, int it, LAS float* scr) {
    const int kc = it / 48, jc = it % 48, lane = F.lane;
#pragma unroll
    for (int s = 0; s < NSEQ; ++s) { const float* cp = s < 4 ? F.in[2] + s * D : F.in[3] + (s - 4) * D;
#pragma unroll
        for (int i = 0; i < 4; ++i) { const float v = cp[kc * 256 + lane + 64 * i]; scr[s * 256 + lane + 64 * i] = v / (1.0f + __expf(-v)); } }
    LDS_WAIT(); asm volatile("" ::: "memory");
    f32x4 acc[NSEQ];
#pragma unroll
    for (int s = 0; s < NSEQ; ++s) acc[s] = (f32x4){0.f, 0.f, 0.f, 0.f};
    const float* wp = F.in[4] + (size_t)(kc * 256) * MODW + jc * 256 + 4 * lane;
#pragma unroll 8
    for (int k = 0; k < 256; ++k) { const f32x4 w = *(const f32x4*)(wp + (size_t)k * MODW);
#pragma unroll
        for (int s = 0; s < NSEQ; ++s) acc[s] += w * scr[s * 256 + k]; }
    float* modp = (float*)(F.ws + WS_MODP);
#pragma unroll
    for (int s = 0; s < NSEQ; ++s) *(f32x4*)(modp + (size_t)(kc * NSEQ + s) * MODW + jc * 256 + 4 * lane) = acc[s];
    LDS_WAIT(); asm volatile("" ::: "memory");
}
__device__ __forceinline__ int q8(float v) { return (int)rintf(fminf(fmaxf(v, -127.0f), 127.0f)); }
__device__ __forceinline__ unsigned q8x4(float a, float b, float c, float d, float inv) {
    typedef float f2_t __attribute__((ext_vector_type(2))); const f2_t mm = {inv, inv}, mg = {12582912.0f, 12582912.0f};
    const f2_t y0 = __builtin_elementwise_fma((f2_t){a, b}, mm, mg), y1 = __builtin_elementwise_fma((f2_t){c, d}, mm, mg);
    return __builtin_amdgcn_perm(__builtin_amdgcn_perm(__float_as_uint(y1.y), __float_as_uint(y1.x), 0x0c0c0400u), __builtin_amdgcn_perm(__float_as_uint(y0.y), __float_as_uint(y0.x), 0x0c0c0400u), 0x05040100u);
}
template <int NC, int FMT  , int K> __device__ __forceinline__ void strip_item(const Frame& F, const float* W, int ldw, unsigned char* dst, size_t dst_pitch, float* scale_out) {
    constexpr int CGS = NC / 4, RPW = 64 / CGS;
    const int lane = F.lane, w = F.wave, cg = lane % CGS, rp = lane / CGS;
    LAS unsigned* strip = (LAS unsigned*)(F.lds + RING_OFF); LAS float* cmx = (LAS float*)(F.lds + AUX_OFF + 2048);
    constexpr int PITCH = K / 2; const int swA = (NC == 32 ? 4 : 8) * cg;
    float mx[4] = {0.f, 0.f, 0.f, 0.f};
    constexpr int rows_per_step = NWAVES * 2 * RPW, nsteps = K / rows_per_step;
    const float* wp = W + (size_t)(w * 2 * RPW + 2 * rp) * ldw + 4 * cg;
    f32x4 ra0[4], rb0[4], ra1[4], rb1[4];
#define ST_LOAD(ra, rb, s0) do { _Pragma("unroll") for (int u = 0; u < 4; ++u) if ((s0) + u < nsteps) { const float* q = wp + (size_t)((s0) + u) * rows_per_step * ldw; ra[u] = *(const f32x4*)q; rb[u] = *(const f32x4*)(q + ldw); } } while (0)
#define ST_PROC(ra, rb, s0) do { _Pragma("unroll") for (int u = 0; u < 4; ++u) if ((s0) + u < nsteps) { const int kp = (((s0) + u) * rows_per_step) / 2 + w * RPW + rp; \
        _Pragma("unroll") for (int c = 0; c < 4; ++c) { mx[c] = fmaxf(mx[c], fmaxf(fabsf(ra[u][c]), fabsf(rb[u][c]))); strip[(4 * cg + c) * PITCH + (kp ^ swA)] = cvt_pk_bf16(ra[u][c], rb[u][c]); } } } while (0)
    ST_LOAD(ra0, rb0, 0);
#pragma unroll
    for (int st = 0; st < nsteps; st += 8) {
        if (st + 4 < nsteps) ST_LOAD(ra1, rb1, st + 4);
        ST_PROC(ra0, rb0, st);
        if (st + 8 < nsteps) ST_LOAD(ra0, rb0, st + 8);
        if (st + 4 < nsteps) ST_PROC(ra1, rb1, st + 4);
    }
#undef ST_LOAD
#undef ST_PROC
#pragma unroll
    for (int c = 0; c < 4; ++c) { float m = mx[c];
#pragma unroll
        for (int o = CGS; o < 64; o <<= 1) m = fmaxf(m, __shfl_xor(m, o));
        if (rp == 0) cmx[w * NC + 4 * cg + c] = m; }
    __syncthreads();
    constexpr int CPW = NC / NWAVES;
    constexpr int nchunk = K / 8;
#pragma unroll
    for (int ci = 0; ci < CPW; ++ci) { const int n = w * CPW + ci; float amax = 0.f;
#pragma unroll
        for (int ww = 0; ww < NWAVES; ++ww) amax = fmaxf(amax, cmx[ww * NC + n]);
        const int swq = (NC == 32 ? 1 : 2) * ((n >> 2) % CGS);
        float mul, deq;
        if (FMT == 1) { mul = amax > 0.f ? 127.0f / amax : 0.f; deq = amax * (1.0f / 127.0f); }
        else if (FMT == 2) { const int sft = amax > 0.f ? (int)floorf(log2f(448.0f / amax)) : 0; mul = exp2f((float)sft); deq = exp2f(-(float)sft); }
        else { mul = 1.f; deq = 1.f; }
        const LAS unsigned char* rowp = (const LAS unsigned char*)(strip + n * PITCH); unsigned char* drow = dst + (size_t)n * dst_pitch;
        for (int pc = lane; pc < nchunk; pc += 64) { const v4u x = *(const LAS v4u*)(rowp + pc * 16); const int q = pc ^ swq;
            if (FMT == 0) *(v4u*)(drow + q * 16) = x;
            else if (FMT == 1) { v2u o; o.x = q8x4(bf_lo(x.x), bf_hi(x.x), bf_lo(x.y), bf_hi(x.y), mul); o.y = q8x4(bf_lo(x.z), bf_hi(x.z), bf_lo(x.w), bf_hi(x.w), mul); *(v2u*)(drow + q * 8) = o; }
            else { v2u o; unsigned t = 0u; t = __builtin_amdgcn_cvt_pk_fp8_f32(bf_lo(x.x) * mul, bf_hi(x.x) * mul, t, false); t = __builtin_amdgcn_cvt_pk_fp8_f32(bf_lo(x.y) * mul, bf_hi(x.y) * mul, t, true); o.x = t;
                t = __builtin_amdgcn_cvt_pk_fp8_f32(bf_lo(x.z) * mul, bf_hi(x.z) * mul, t, false); t = __builtin_amdgcn_cvt_pk_fp8_f32(bf_lo(x.w) * mul, bf_hi(x.w) * mul, t, true); o.y = t; *(v2u*)(drow + q * 8) = o; } }
        if (FMT != 0 && lane == 0) scale_out[n] = deq; }
    __syncthreads();
}
__device__ __forceinline__ void p0_prologue(const Frame& F) {
    { LAS float* scr = (LAS float*)(F.lds + RING_OFF + F.wave * 16384);
      const int gw = F.vcu * NWAVES + F.wave, NGW = F.G * NWAVES; constexpr int I_ADA = ADA_KC * 48, I_SGW = 64;
      for (int it = gw; it < I_ADA + I_SGW; it += NGW) {
          if (it < I_ADA) { ada_item(F, it, scr); continue; }
          const int r = it - I_ADA; const float* src = F.in[14] + (size_t)r * 4096; bf16* dst = (bf16*)(F.ws + WS_SGW) + (size_t)r * 4096;
#pragma unroll
          for (int q = 0; q < 8; ++q) { const f32x4 a = *(const f32x4*)(src + 8 * (F.lane + 64 * q)), b = *(const f32x4*)(src + 8 * (F.lane + 64 * q) + 4);
              v4u o; o.x = cvt_pk_bf16(a.x, a.y); o.y = cvt_pk_bf16(a.z, a.w); o.z = cvt_pk_bf16(b.x, b.y); o.w = cvt_pk_bf16(b.z, b.w); *(v4u*)(dst + 8 * (F.lane + 64 * q)) = o; } } }
    __syncthreads();
    constexpr int S_IN = IN_W / 32, S_O = D / 32, S_GU = NE * 2 * (FF / 32), S_DN = NE * (D / 16), NSTRIP = S_IN + 3 * S_O + S_GU + S_DN;
    unsigned char* const ws = F.ws;
    for (int it = F.vcu; it < NSTRIP; it += F.G) {
        int r = it;
        if (r < S_GU) { const int mat = r / (FF / 32), nb = r % (FF / 32), e = mat >> 1, up = mat & 1, n0 = 32 * nb;
            const size_t drow = (size_t)(e * 22 + n0 / 128) * 256 + up * 128 + (n0 % 128);
            strip_item<32, 1, D>(F, F.in[up ? 21 : 20] + (size_t)e * D * FF + n0, FF, ws + WS_WGU + drow * D, D, (float*)(ws + WS_SGU) + drow); continue; } r -= S_GU;
        if (r < S_DN) { const int e = r / (D / 16), n0 = 16 * (r % (D / 16));
            strip_item<16, 2, FF>(F, F.in[22] + (size_t)e * FF * D + n0, D, ws + WS_WD + ((size_t)e * D + n0) * FF, FF, (float*)(ws + WS_WSC) + e * D + n0); continue; } r -= S_DN;
        if (r < S_IN) { const int n0 = 32 * r; strip_item<32, 1, D>(F, F.in[8] + n0, IN_W, ws + WS_WIN8 + (size_t)n0 * D, D, (float*)(ws + WS_SWIN) + n0); continue; } r -= S_IN;
        { const int wsel = r / S_O, n0 = 32 * (r % S_O);
          if (wsel == 0) strip_item<32, 2, D>(F, F.in[16] + n0, D, ws + WS_WOA8 + (size_t)n0 * D, D, (float*)(ws + WS_WSCO) + n0);
          else if (wsel == 1) strip_item<32, 0, D>(F, F.in[17] + n0, D, ws + WS_WOS + (size_t)n0 * D * 2, D * 2, nullptr);
          else strip_item<32, 1, D>(F, F.in[18] + n0, D, ws + WS_WOUT + (size_t)n0 * D, D, (float*)(ws + WS_SWO) + n0); }
    }
}

template <int WHICH> __device__ __forceinline__ void load_modl(const Frame& F, int s, LAS float* modl) {
    const float* modp = (const float*)(F.ws + WS_MODP); const float* mod = (const float*)(F.ws + WS_MOD); const float* bada = F.in[5];
    for (int j = F.tid; j < 2 * D; j += NWAVES * 64) {
        float v;
        if (WHICH == 1) { const int col = j; v = bada[col];
#pragma unroll
            for (int kc = 0; kc < ADA_KC; ++kc) v += modp[(size_t)(kc * NSEQ + s) * MODW + col]; }
        else v = mod[(size_t)s * MODW + 3 * D + j];
        modl[j] = (j >= D) ? (1.0f + v) * F.in[WHICH == 1 ? 6 : 7][j - D] : v;
    }
}
__device__ __forceinline__ void p1_rows(const Frame& F) {
    LAS float* modl = (LAS float*)(F.lds + AUX_OFF);
    { const float* modp = (const float*)(F.ws + WS_MODP); float* mod = (float*)(F.ws + WS_MOD); const float* bada = F.in[5];
      for (int idx = F.vcu * 512 + F.tid; idx < NSEQ * MODW; idx += F.G * 512) { const int s = idx / MODW, j = idx % MODW; float v = bada[j];
#pragma unroll
          for (int kc = 0; kc < ADA_KC; ++kc) v += modp[(size_t)(kc * NSEQ + s) * MODW + j];
          mod[idx] = v; } }
    const int RPB = (M + F.G - 1) / F.G, r0 = F.vcu * RPB, r1 = (r0 + RPB < M) ? r0 + RPB : M;
    unsigned* h1q = (unsigned*)(F.ws + WS_H1Q); float* hs1 = (float*)(F.ws + WS_HS1);
    const float* g1n = F.in[6]; bf16* h1 = (DBG_NPH == 3) ? (bf16*)(F.ws + WS_WGU) : (bf16*)((unsigned char*)F.out + DO_H1);
    for (int row = r0; row < r1;) {
        const int s = seq_of(row); int end = seq_start(s) + seq_len(s); if (end > r1) end = r1;
        load_modl<1>(F, s, modl);
        __syncthreads();
        f32x4 vn[8];
        { const int mf = row + F.wave; if (mf < end) { const f32x4* xr = (const f32x4*)xrow_ptr(F, mf) + F.lane;
#pragma unroll
            for (int j = 0; j < 8; ++j) vn[j] = xr[64 * j]; } }
        for (int m = row + F.wave; m < end; m += NWAVES) {
            f32x4 v[8]; float ss = 0.f;
#pragma unroll
            for (int j = 0; j < 8; ++j) v[j] = vn[j];
            if (m + NWAVES < end) { const f32x4* xr = (const f32x4*)xrow_ptr(F, m + NWAVES) + F.lane;
#pragma unroll
                for (int j = 0; j < 8; ++j) vn[j] = xr[64 * j]; }
#pragma unroll
            for (int j = 0; j < 8; ++j) ss += (v[j].x * v[j].x + v[j].y * v[j].y) + (v[j].z * v[j].z + v[j].w * v[j].w);
            const float rstd = 1.0f / sqrtf(wave_sum(ss) * (1.0f / D) + NORM_EPS);
            float amax = 0.f;
#pragma unroll
            for (int j = 0; j < 8; ++j) { const int d = 4 * (F.lane + 64 * j);
                const f32x4 sh = *(const LAS f32x4*)(modl + d), sc = *(const LAS f32x4*)(modl + D + d);
                const f32x4 y = v[j] * rstd * sc + sh; v[j] = y; amax = fmaxf(fmaxf(amax, fmaxf(fabsf(y.x), fabsf(y.y))), fmaxf(fabsf(y.z), fabsf(y.w)));
                }
            amax = wave_max(amax);
            { const float inv = amax > 0.f ? 127.0f / amax : 0.f; unsigned* o4 = h1q + (size_t)m * (D / 4) + F.lane;
#pragma unroll
              for (int j = 0; j < 8; ++j) o4[64 * j] = q8x4(v[j].x, v[j].y, v[j].z, v[j].w, inv);
              if (F.lane == 0) hs1[m] = amax * (1.0f / 127.0f); }
        }
        __syncthreads();
        row = end;
    }
}
__device__ __forceinline__ void p6_rows(const Frame& F) {
    LAS float* modl = (LAS float*)(F.lds + AUX_OFF);
    LAS float* wrt = (LAS float*)(F.lds + RING_OFF);
    { const float* wr = F.in[19]; for (int idx = F.tid; idx < D * NE; idx += NWAVES * 64) wrt[(idx & 15) * D + (idx >> 4)] = wr[idx]; }
    const int RPB = (M + F.G - 1) / F.G, r0 = F.vcu * RPB, r1 = (r0 + RPB < M) ? r0 + RPB : M;
    const float* g2n = F.in[7]; unsigned* h2q = (unsigned*)(F.ws + WS_Q); float* hs = (float*)(F.ws + WS_HS);
    float* aff = (float*)(F.ws + WS_AFF); float* affT = (float*)(F.ws + WS_AFFT);
    for (int row = r0; row < r1;) {
        const int s = seq_of(row); int end = seq_start(s) + seq_len(s); if (end > r1) end = r1;
        load_modl<2>(F, s, modl);
        __syncthreads();
        f32x4 vn0[8], vn1[8];
        { const int mf = row + 2 * F.wave; if (mf < end) { const int mf1 = mf + 1 < end ? mf + 1 : mf; const f32x4* x0 = (const f32x4*)(F.out + (size_t)mf * D) + F.lane; const f32x4* x1 = (const f32x4*)(F.out + (size_t)mf1 * D) + F.lane;
#pragma unroll
            for (int j = 0; j < 8; ++j) { vn0[j] = x0[64 * j]; vn1[j] = x1[64 * j]; } } }
        for (int m = row + 2 * F.wave; m < end; m += 2 * NWAVES) {
            const bool two = m + 1 < end; const int m1 = two ? m + 1 : m;
            f32x4 v0[8], v1[8]; float ss0 = 0.f, ss1 = 0.f;
#pragma unroll
            for (int j = 0; j < 8; ++j) { v0[j] = vn0[j]; v1[j] = vn1[j]; }
            if (m + 2 * NWAVES < end) { const int mn = m + 2 * NWAVES, mn1 = mn + 1 < end ? mn + 1 : mn; const f32x4* x0 = (const f32x4*)(F.out + (size_t)mn * D) + F.lane; const f32x4* x1 = (const f32x4*)(F.out + (size_t)mn1 * D) + F.lane;
#pragma unroll
                for (int j = 0; j < 8; ++j) { vn0[j] = x0[64 * j]; vn1[j] = x1[64 * j]; } }
#pragma unroll
            for (int j = 0; j < 8; ++j) { ss0 += (v0[j].x * v0[j].x + v0[j].y * v0[j].y) + (v0[j].z * v0[j].z + v0[j].w * v0[j].w); ss1 += (v1[j].x * v1[j].x + v1[j].y * v1[j].y) + (v1[j].z * v1[j].z + v1[j].w * v1[j].w); }
            const float rstd0 = 1.0f / sqrtf(wave_sum(ss0) * (1.0f / D) + NORM_EPS), rstd1 = 1.0f / sqrtf(wave_sum(ss1) * (1.0f / D) + NORM_EPS);
            float amax0 = 0.f, amax1 = 0.f;
#pragma unroll
            for (int j = 0; j < 8; ++j) { const int d = 4 * (F.lane + 64 * j);
                const f32x4 sh = *(const LAS f32x4*)(modl + d), gs = *(const LAS f32x4*)(modl + D + d);
                const f32x4 y0 = v0[j] * rstd0 * gs + sh, y1 = v1[j] * rstd1 * gs + sh; v0[j] = y0; v1[j] = y1;
                amax0 = fmaxf(fmaxf(amax0, fmaxf(fabsf(y0.x), fabsf(y0.y))), fmaxf(fabsf(y0.z), fabsf(y0.w))); amax1 = fmaxf(fmaxf(amax1, fmaxf(fabsf(y1.x), fabsf(y1.y))), fmaxf(fabsf(y1.z), fabsf(y1.w))); }
            amax0 = wave_max(amax0); amax1 = wave_max(amax1);
            { const float inv = amax0 > 0.f ? 127.0f / amax0 : 0.f; unsigned* o4 = h2q + (size_t)m * (D / 4) + F.lane;
#pragma unroll
              for (int j = 0; j < 8; ++j) o4[64 * j] = q8x4(v0[j].x, v0[j].y, v0[j].z, v0[j].w, inv);
              if (F.lane == 0) hs[m] = amax0 * (1.0f / 127.0f); }
            if (two) { const float inv = amax1 > 0.f ? 127.0f / amax1 : 0.f; unsigned* o4 = h2q + (size_t)m1 * (D / 4) + F.lane;
#pragma unroll
              for (int j = 0; j < 8; ++j) o4[64 * j] = q8x4(v1[j].x, v1[j].y, v1[j].z, v1[j].w, inv);
              if (F.lane == 0) hs[m1] = amax1 * (1.0f / 127.0f); }
            asm volatile("" ::: "memory");
            float lg0[NE], lg1[NE];
#pragma unroll
            for (int e = 0; e < NE; ++e) { f32x4 a0 = {0.f, 0.f, 0.f, 0.f}, a1 = {0.f, 0.f, 0.f, 0.f};
#pragma unroll
                for (int j = 0; j < 8; ++j) { const f32x4 wv = *(const LAS f32x4*)(wrt + e * D + 4 * (F.lane + 64 * j)); a0 += v0[j] * wv; a1 += v1[j] * wv; }
                lg0[e] = (a0.x + a0.y) + (a0.z + a0.w); lg1[e] = (a1.x + a1.y) + (a1.z + a1.w); asm volatile("" ::: "memory"); }
            const int ln = F.lane;
#define P6_TREDUCE(lg, lgt) do { float r8[8], r4[4], r2[2]; \
            { const bool hb = (ln >> 5) & 1; _Pragma("unroll") for (int i = 0; i < 8; ++i) { const float keep = hb ? lg[8 + i] : lg[i], send = hb ? lg[i] : lg[8 + i]; r8[i] = keep + __shfl_xor(send, 32); } } \
            { const bool hb = (ln >> 4) & 1; _Pragma("unroll") for (int i = 0; i < 4; ++i) { const float keep = hb ? r8[4 + i] : r8[i], send = hb ? r8[i] : r8[4 + i]; r4[i] = keep + __shfl_xor(send, 16); } } \
            { const bool hb = (ln >> 3) & 1; _Pragma("unroll") for (int i = 0; i < 2; ++i) { const float keep = hb ? r4[2 + i] : r4[i], send = hb ? r4[i] : r4[2 + i]; r2[i] = keep + __shfl_xor(send, 8); } } \
            { const bool hb = (ln >> 2) & 1; const float keep = hb ? r2[1] : r2[0], send = hb ? r2[0] : r2[1]; lgt = keep + __shfl_xor(send, 4); } \
            lgt += __shfl_xor(lgt, 1); lgt += __shfl_xor(lgt, 2); } while (0)
#define P6_SOFTMAX_STORE(lgt, mrow) do { float mx = lgt; _Pragma("unroll") for (int o = 4; o < 64; o <<= 1) mx = fmaxf(mx, __shfl_xor(mx, o)); \
            const float ex = expf(lgt - mx); float den = ex; _Pragma("unroll") for (int o = 4; o < 64; o <<= 1) den += __shfl_xor(den, o); \
            const float mine = ex / den; const int e = ln >> 2; \
            if ((ln & 3) == 0) { aff[(size_t)(mrow) * NE + e] = mine; \
                if ((mrow) < TP) affT[(size_t)e * TP + (mrow)] = mine; else affT[(size_t)NE * TP + (size_t)e * TS + ((mrow) - TP)] = mine; } } while (0)
            float lgt0, lgt1; P6_TREDUCE(lg0, lgt0); P6_TREDUCE(lg1, lgt1);
            P6_SOFTMAX_STORE(lgt0, m);
            if (two) P6_SOFTMAX_STORE(lgt1, m1);
#undef P6_TREDUCE
#undef P6_SOFTMAX_STORE
        }
        __syncthreads();
        row = end;
    }
}

using pg8::Unit; using pg8::bf16_t;
__device__ __forceinline__ float gelu_tanh(float x) { const float t = x * (1.0f + 0.044715f * x * x) * (-2.0f * 0.7978845608028654f * 1.4426950408889634f); return x * __builtin_amdgcn_rcpf(1.0f + __builtin_amdgcn_exp2f(t)); }
__device__ __forceinline__ float sigmoid_f(float x) { return __builtin_amdgcn_rcpf(1.0f + __builtin_amdgcn_exp2f(-1.4426950408889634f * x)); }
template <int ACT> __device__ __forceinline__ float act_f(float x) { return ACT == 1 ? gelu_tanh(x) : (ACT == 2 || ACT == 3) ? sigmoid_f(x) : x; }
template <int ACT> __device__ __forceinline__ void store_tile_bf16(const f32x4 (&acc)[2][2][4][2], bf16_t* base, int ldc, int row0, int col0) {
#pragma unroll
    for (int ai = 0; ai < 2; ++ai)
#pragma unroll
        for (int m = 0; m < 4; ++m) { bf16_t* rowp = base + (size_t)(row0 + ai * 128 + m * 16) * ldc + col0;
#pragma unroll
            for (int bj = 0; bj < 2; ++bj) { const f32x4 v0 = acc[ai][bj][m][0], v1 = acc[ai][bj][m][1]; v4u w;
                w.x = cvt_pk_bf16(act_f<ACT>(v0[0]), act_f<ACT>(v0[1])); w.y = cvt_pk_bf16(act_f<ACT>(v0[2]), act_f<ACT>(v0[3]));
                w.z = cvt_pk_bf16(act_f<ACT>(v1[0]), act_f<ACT>(v1[1])); w.w = cvt_pk_bf16(act_f<ACT>(v1[2]), act_f<ACT>(v1[3]));
                *(v4u*)(rowp + bj * 128) = w; } }
}
struct EpiIn {
    bf16_t *Q, *Kb, *Vb, *U, *VG, *GA, *GS; float* VST;
    __device__ __forceinline__ void operator()(const f32x4 (&acc)[2][2][4][2], const Unit& u, int wr, int wc, int fr, int fq) const {
        const int pn = u.pn; bf16_t* base; int ldc, colt, act;
        if (pn < 8) { base = Q; ldc = D; colt = pn * 256; act = 0; }
        else if (pn < 10) { base = Kb; ldc = KVW; colt = (pn - 8) * 256; act = 0; }
        else if (pn < 12) { base = Vb; ldc = KVW; colt = (pn - 10) * 256; act = 0; }
        else if (pn < 20) { base = U; ldc = D; colt = (pn - 12) * 256; act = 1; }
        else if (pn < 28) { base = VG; ldc = D; colt = (pn - 20) * 256; act = 1; }
        else if (pn < 36) { base = GA; ldc = D; colt = (pn - 28) * 256; act = 2; }
        else { base = GS; ldc = D; colt = (pn - 36) * 256; act = 2; }
        const int row0 = u.pm * 256 + wr * 64 + fr, col0 = colt + wc * 32 + 8 * fq;
        if (act == 0) store_tile_bf16<0>(acc, base, ldc, row0, col0);
        else if (act == 2) store_tile_bf16<2>(acc, base, ldc, row0, col0);
        else if (pn < 20) store_tile_bf16<1>(acc, base, ldc, row0, col0);
        else {
            const int fq_ = fq;
#pragma unroll
            for (int ai = 0; ai < 2; ++ai)
#pragma unroll
                for (int m = 0; m < 4; ++m) { const int row = row0 + ai * 128 + m * 16; bf16_t* rowp = base + (size_t)row * ldc + col0; float s1 = 0.f, s2 = 0.f;
#pragma unroll
                    for (int bj = 0; bj < 2; ++bj) { const f32x4 v0 = acc[ai][bj][m][0], v1 = acc[ai][bj][m][1];
                        const float a0 = gelu_tanh(v0[0]), a1 = gelu_tanh(v0[1]), a2 = gelu_tanh(v0[2]), a3 = gelu_tanh(v0[3]), a4 = gelu_tanh(v1[0]), a5 = gelu_tanh(v1[1]), a6 = gelu_tanh(v1[2]), a7 = gelu_tanh(v1[3]);
                        s1 += ((a0 + a1) + (a2 + a3)) + ((a4 + a5) + (a6 + a7)); s2 += ((a0 * a0 + a1 * a1) + (a2 * a2 + a3 * a3)) + ((a4 * a4 + a5 * a5) + (a6 * a6 + a7 * a7));
                        v4u w; w.x = cvt_pk_bf16(a0, a1); w.y = cvt_pk_bf16(a2, a3); w.z = cvt_pk_bf16(a4, a5); w.w = cvt_pk_bf16(a6, a7); *(v4u*)(rowp + bj * 128) = w; }
                    s1 += __shfl_xor(s1, 16); s1 += __shfl_xor(s1, 32); s2 += __shfl_xor(s2, 16); s2 += __shfl_xor(s2, 32);
                    if (fq_ == 0) { float2 st2; st2.x = s1; st2.y = s2; *(float2*)(VST + ((size_t)row * 32 + (pn - 20) * 4 + wc) * 2) = st2; } }
        }
    }
};
template <int ACT> __device__ __forceinline__ void store_tile_i8(const pg8::i32x4 (&acc)[2][2][4][2], bf16_t* base, int ldc, int row0, int col0, const float* hs1, const float* sp) {
    f32x4 sc[2][2];
#pragma unroll
    for (int bj = 0; bj < 2; ++bj) { sc[bj][0] = *(const f32x4*)(sp + bj * 128); sc[bj][1] = *(const f32x4*)(sp + bj * 128 + 4); }
#pragma unroll
    for (int ai = 0; ai < 2; ++ai)
#pragma unroll
        for (int m = 0; m < 4; ++m) { const int row = row0 + ai * 128 + m * 16; const float xr = hs1[row]; bf16_t* rowp = base + (size_t)row * ldc + col0;
#pragma unroll
            for (int bj = 0; bj < 2; ++bj) { const pg8::i32x4 i0 = acc[ai][bj][m][0], i1 = acc[ai][bj][m][1];
                const f32x4 z0 = (f32x4){(float)i0[0], (float)i0[1], (float)i0[2], (float)i0[3]} * sc[bj][0] * xr, z1 = (f32x4){(float)i1[0], (float)i1[1], (float)i1[2], (float)i1[3]} * sc[bj][1] * xr; v4u w;
                if constexpr (ACT == 3) {
                    unsigned lo = 0u, hi = 0u;
                    lo = __builtin_amdgcn_cvt_pk_u8_f32(rintf(255.0f * sigmoid_f(z0[0])), 0, lo); lo = __builtin_amdgcn_cvt_pk_u8_f32(rintf(255.0f * sigmoid_f(z0[1])), 1, lo); lo = __builtin_amdgcn_cvt_pk_u8_f32(rintf(255.0f * sigmoid_f(z0[2])), 2, lo); lo = __builtin_amdgcn_cvt_pk_u8_f32(rintf(255.0f * sigmoid_f(z0[3])), 3, lo);
                    hi = __builtin_amdgcn_cvt_pk_u8_f32(rintf(255.0f * sigmoid_f(z1[0])), 0, hi); hi = __builtin_amdgcn_cvt_pk_u8_f32(rintf(255.0f * sigmoid_f(z1[1])), 1, hi); hi = __builtin_amdgcn_cvt_pk_u8_f32(rintf(255.0f * sigmoid_f(z1[2])), 2, hi); hi = __builtin_amdgcn_cvt_pk_u8_f32(rintf(255.0f * sigmoid_f(z1[3])), 3, hi);
                    *(v2u*)((unsigned char*)base + (size_t)row * ldc + col0 + bj * 128) = (v2u){lo, hi}; continue; }
                w.x = cvt_pk_bf16(act_f<ACT>(z0[0]), act_f<ACT>(z0[1])); w.y = cvt_pk_bf16(act_f<ACT>(z0[2]), act_f<ACT>(z0[3])); w.z = cvt_pk_bf16(act_f<ACT>(z1[0]), act_f<ACT>(z1[1])); w.w = cvt_pk_bf16(act_f<ACT>(z1[2]), act_f<ACT>(z1[3]));
                *(v4u*)(rowp + bj * 128) = w; } }
}
struct EpiGate {
    bf16_t *Q, *Kb, *Vb, *U, *VG, *GA, *GS; float* VST; const float* hs1; const float* swin; const float* gq; const float* gk; LAS float* P; float* US; float* VS;
    __device__ __forceinline__ void operator()(const pg8::i32x4 (&acc)[2][2][4][2], const Unit& u, int wr, int wc, int fr, int fq) const {
        asm volatile("" : "+v"(fr), "+v"(fq));
        const int pn = u.pn; bf16_t* base; int ldc, colt;
        if (pn < 8) { base = Q; ldc = D; colt = pn * 256; }
        else if (pn < 10) { base = Kb; ldc = KVW; colt = (pn - 8) * 256; }
        else if (pn < 12) { base = Vb; ldc = KVW; colt = (pn - 10) * 256; }
        else if (pn < 20) { base = U; ldc = D; colt = (pn - 12) * 256; }
        else if (pn < 28) { base = VG; ldc = D; colt = (pn - 20) * 256; }
        else if (pn < 36) { base = GA; ldc = D; colt = (pn - 28) * 256; }
        else { base = GS; ldc = D; colt = (pn - 36) * 256; }
        const int row0 = u.pm * 256 + wr * 64 + fr, col0 = colt + wc * 32 + 8 * fq; const float* sp = swin + pn * 256 + wc * 32 + 8 * fq;
        if (pn < 10) {
            f32x4 sc[2][2];
#pragma unroll
            for (int bj = 0; bj < 2; ++bj) { sc[bj][0] = *(const f32x4*)(sp + bj * 128); sc[bj][1] = *(const f32x4*)(sp + bj * 128 + 4); }
#pragma unroll
            for (int ai = 0; ai < 2; ++ai)
#pragma unroll
                for (int m = 0; m < 4; ++m) { const int rl = ai * 128 + wr * 64 + m * 16 + fr; const float xr = hs1[u.pm * 256 + rl];
#pragma unroll
                    for (int bj = 0; bj < 2; ++bj) { const pg8::i32x4 i0 = acc[ai][bj][m][0], i1 = acc[ai][bj][m][1];
                        const f32x4 z0 = (f32x4){(float)i0[0], (float)i0[1], (float)i0[2], (float)i0[3]} * sc[bj][0] * xr, z1 = (f32x4){(float)i1[0], (float)i1[1], (float)i1[2], (float)i1[3]} * sc[bj][1] * xr;
                        float ss = ((z0[0] * z0[0] + z0[1] * z0[1]) + (z0[2] * z0[2] + z0[3] * z0[3])) + ((z1[0] * z1[0] + z1[1] * z1[1]) + (z1[2] * z1[2] + z1[3] * z1[3]));
                        ss += __shfl_xor(ss, 16); ss += __shfl_xor(ss, 32);
                        if (fq == 0) P[(rl * 2 + bj) * 4 + wc] = ss; } }
            asm volatile("s_waitcnt lgkmcnt(0)" ::: "memory"); __builtin_amdgcn_s_barrier(); asm volatile("" ::: "memory");
            if (pn < 8) { const int d = wc * 32 + 8 * fq; const f32x4 g0 = *(const f32x4*)(gq + d) * *(const f32x4*)(gk + d) * (0.08838834764831845f * 1.4426950408889634f), g1 = *(const f32x4*)(gq + d + 4) * *(const f32x4*)(gk + d + 4) * (0.08838834764831845f * 1.4426950408889634f);
#pragma unroll
                for (int bj = 0; bj < 2; ++bj) { sc[bj][0] *= g0; sc[bj][1] *= g1; } }
#pragma unroll
            for (int ai = 0; ai < 2; ++ai)
#pragma unroll
                for (int m = 0; m < 4; ++m) { const int rl = ai * 128 + wr * 64 + m * 16 + fr; const int row = u.pm * 256 + rl; const float xr = hs1[row]; bf16_t* rowp = base + (size_t)row * ldc + col0;
#pragma unroll
                    for (int bj = 0; bj < 2; ++bj) { const pg8::i32x4 i0 = acc[ai][bj][m][0], i1 = acc[ai][bj][m][1]; const f32x4 pp = *(const LAS f32x4*)(P + (rl * 2 + bj) * 4);
                        const float rn = (1.0f / sqrtf(((pp.x + pp.y) + (pp.z + pp.w)) * (1.0f / 128.0f) + NORM_EPS)) * xr;
                        const f32x4 z0 = (f32x4){(float)i0[0], (float)i0[1], (float)i0[2], (float)i0[3]} * sc[bj][0] * rn, z1 = (f32x4){(float)i1[0], (float)i1[1], (float)i1[2], (float)i1[3]} * sc[bj][1] * rn; v4u w;
                        w.x = cvt_pk_bf16(z0[0], z0[1]); w.y = cvt_pk_bf16(z0[2], z0[3]); w.z = cvt_pk_bf16(z1[0], z1[1]); w.w = cvt_pk_bf16(z1[2], z1[3]);
                        *(v4u*)(rowp + bj * 128) = w; } }
        }
        else if (pn < 12) store_tile_i8<0>(acc, base, ldc, row0, col0, hs1, sp);
        else if (pn >= 28) store_tile_i8<3>(acc, base, ldc, row0, col0, hs1, sp);
        else {
            const bool isvg = pn >= 20; const int tile = isvg ? pn - 20 : pn - 12; unsigned char* const base8 = (unsigned char*)(isvg ? (void*)VG : (void*)U); float* const stab = isvg ? VS : US;
            f32x4 sc[2][2];
#pragma unroll
            for (int bj = 0; bj < 2; ++bj) { sc[bj][0] = *(const f32x4*)(sp + bj * 128); sc[bj][1] = *(const f32x4*)(sp + bj * 128 + 4); }
#pragma unroll
            for (int ai = 0; ai < 2; ++ai)
#pragma unroll
                for (int m = 0; m < 4; ++m) { const int rl = ai * 128 + wr * 64 + m * 16 + fr; const float xr = *(const float*)((const char*)hs1 + (size_t)((unsigned)(u.pm * 256 + rl) * 4u)); float zm = -1.0e30f;
#pragma unroll
                    for (int bj = 0; bj < 2; ++bj) { const pg8::i32x4 i0 = acc[ai][bj][m][0], i1 = acc[ai][bj][m][1];
                        const f32x4 z0 = (f32x4){(float)i0[0], (float)i0[1], (float)i0[2], (float)i0[3]} * sc[bj][0] * xr, z1 = (f32x4){(float)i1[0], (float)i1[1], (float)i1[2], (float)i1[3]} * sc[bj][1] * xr;
                        zm = fmaxf(zm, fmaxf(fmaxf(fmaxf(z0[0], z0[1]), fmaxf(z0[2], z0[3])), fmaxf(fmaxf(z1[0], z1[1]), fmaxf(z1[2], z1[3])))); }
                    zm = fmaxf(zm, __shfl_xor(zm, 16)); zm = fmaxf(zm, __shfl_xor(zm, 32));
                    if (fq == 0) P[rl * 4 + wc] = zm; }
            asm volatile("s_waitcnt lgkmcnt(0)" ::: "memory"); __builtin_amdgcn_s_barrier(); asm volatile("" ::: "memory");
            int fr2 = fr, fq2 = fq; asm volatile("" : "+v"(fr2), "+v"(fq2));
#pragma unroll
            for (int bj = 0; bj < 2; ++bj) { sc[bj][0] = *(const f32x4*)(sp + bj * 128); sc[bj][1] = *(const f32x4*)(sp + bj * 128 + 4); }
#pragma unroll
            for (int ai = 0; ai < 2; ++ai)
#pragma unroll
                for (int m = 0; m < 4; ++m) { const int rl = ai * 128 + wr * 64 + m * 16 + fr2; const unsigned row = (unsigned)(u.pm * 256 + rl); const float xr = *(const float*)((const char*)hs1 + (size_t)(row * 4u));
                    const f32x4 pp = *(const LAS f32x4*)(P + rl * 4); const float zrow = fmaxf(fmaxf(pp.x, pp.y), fmaxf(pp.z, pp.w)), A = fmaxf(gelu_tanh(zrow), 0.1701f), inv = 127.0f / A;
                    unsigned char* rowp = base8 + (size_t)(row * (unsigned)D + (unsigned)(tile * 256 + wc * 32 + 8 * fq2)); float s1 = 0.f, s2 = 0.f;
#pragma unroll
                    for (int bj = 0; bj < 2; ++bj) { pg8::i32x4 i0 = acc[ai][bj][m][0], i1 = acc[ai][bj][m][1]; asm volatile("" : "+v"(i0), "+v"(i1));
                        const f32x4 z0 = (f32x4){(float)i0[0], (float)i0[1], (float)i0[2], (float)i0[3]} * sc[bj][0] * xr, z1 = (f32x4){(float)i1[0], (float)i1[1], (float)i1[2], (float)i1[3]} * sc[bj][1] * xr;
                        const float a0 = gelu_tanh(z0[0]), a1 = gelu_tanh(z0[1]), a2 = gelu_tanh(z0[2]), a3 = gelu_tanh(z0[3]), a4 = gelu_tanh(z1[0]), a5 = gelu_tanh(z1[1]), a6 = gelu_tanh(z1[2]), a7 = gelu_tanh(z1[3]);
                        s1 += ((a0 + a1) + (a2 + a3)) + ((a4 + a5) + (a6 + a7)); s2 += ((a0 * a0 + a1 * a1) + (a2 * a2 + a3 * a3)) + ((a4 * a4 + a5 * a5) + (a6 * a6 + a7 * a7));
                        v2u w; w.x = q8x4(a0, a1, a2, a3, inv); w.y = q8x4(a4, a5, a6, a7, inv); *(v2u*)(rowp + bj * 128) = w; }
                    if (isvg) { s1 += __shfl_xor(s1, 16); s1 += __shfl_xor(s1, 32); s2 += __shfl_xor(s2, 16); s2 += __shfl_xor(s2, 32);
                        if (fq2 == 0) { float2 st2; st2.x = s1; st2.y = s2; *(float2*)((char*)VST + (size_t)((row * 32u + (unsigned)(tile * 4 + wc)) * 8u)) = st2; } }
                    if (fq2 == 0 && wc == 0) stab[row * 8u + (unsigned)tile] = A * (1.0f / 127.0f);
                    asm volatile("" ::: "memory"); }
        }
    }
};
struct EpiMerge {
    bf16_t* T; const unsigned char* G8; const float* wsco; int half;
    __device__ __forceinline__ void operator()(const f32x4 (&acc)[2][2][4][2], const Unit& u, int wr, int wc, int fr, int fq) const {
        const int row0 = u.pm * 256 + wr * 64 + fr, col0 = u.pn * 256 + wc * 32 + 8 * fq;
        f32x4 cs[2][2];
#pragma unroll
        for (int bj = 0; bj < 2; ++bj) { cs[bj][0] = (half == 0 ? *(const f32x4*)(wsco + col0 + bj * 128) : (f32x4){1.f, 1.f, 1.f, 1.f}) * (1.0f / 255.0f); cs[bj][1] = (half == 0 ? *(const f32x4*)(wsco + col0 + bj * 128 + 4) : (f32x4){1.f, 1.f, 1.f, 1.f}) * (1.0f / 255.0f); }
#pragma unroll
        for (int ai = 0; ai < 2; ++ai)
#pragma unroll
            for (int m = 0; m < 4; ++m) { const size_t off = (size_t)(row0 + ai * 128 + m * 16) * D + col0;
#pragma unroll
                for (int bj = 0; bj < 2; ++bj) { const f32x4 v0 = acc[ai][bj][m][0] * cs[bj][0], v1 = acc[ai][bj][m][1] * cs[bj][1];
                    const v2u g = *(const v2u*)(G8 + off + bj * 128);
                    f32x4 r0 = (f32x4){(float)(g.x & 255u), (float)((g.x >> 8) & 255u), (float)((g.x >> 16) & 255u), (float)(g.x >> 24)} * v0, r1 = (f32x4){(float)(g.y & 255u), (float)((g.y >> 8) & 255u), (float)((g.y >> 16) & 255u), (float)(g.y >> 24)} * v1;
                    if (half) { const v4u t = *(const v4u*)(T + off + bj * 128); r0 += (f32x4){bf_lo(t.x), bf_hi(t.x), bf_lo(t.y), bf_hi(t.y)}; r1 += (f32x4){bf_lo(t.z), bf_hi(t.z), bf_lo(t.w), bf_hi(t.w)}; }
                    v4u w; w.x = cvt_pk_bf16(r0[0], r0[1]); w.y = cvt_pk_bf16(r0[2], r0[3]); w.z = cvt_pk_bf16(r1[0], r1[1]); w.w = cvt_pk_bf16(r1[2], r1[3]);
                    *(v4u*)(T + off + bj * 128) = w; } }
    }
};
struct EpiOut {
    const float* xp; const float* xs; float* out; const float* mod; const float* ms; const float* swo;
    __device__ __forceinline__ void operator()(const pg8::i32x4 (&acc)[2][2][4][2], const Unit& u, int wr, int wc, int fr, int fq) const {
        asm volatile("" : "+v"(fr), "+v"(fq));
        const int row0 = u.pm * 256 + wr * 64 + fr, col0 = u.pn * 256 + wc * 32 + 8 * fq;
        const int s = seq_of(u.pm * 256);
        const float* xb = u.pm < TP / 256 ? xp : xs - (size_t)TP * D;
        f32x4 g[2][2];
#pragma unroll
        for (int bj = 0; bj < 2; ++bj)
#pragma unroll
            for (int n = 0; n < 2; ++n) g[bj][n] = *(const f32x4*)(mod + (size_t)s * MODW + 2 * D + col0 + bj * 128 + 4 * n) * *(const f32x4*)(swo + col0 + bj * 128 + 4 * n);
#pragma unroll
        for (int ai = 0; ai < 2; ++ai)
#pragma unroll
            for (int m = 0; m < 4; ++m) { const int row = row0 + ai * 128 + m * 16; const size_t off = (size_t)row * D + col0; const float mr = ms[row];
#pragma unroll
                for (int bj = 0; bj < 2; ++bj)
#pragma unroll
                    for (int n = 0; n < 2; ++n) { const f32x4 xv = *(const f32x4*)(xb + off + bj * 128 + 4 * n); const pg8::i32x4 ia = acc[ai][bj][m][n];
                        *(f32x4*)(out + off + bj * 128 + 4 * n) = xv + g[bj][n] * ((f32x4){(float)ia[0], (float)ia[1], (float)ia[2], (float)ia[3]} * mr); } }
    }
};
struct EpiGU {
    unsigned char* ACT; const float* xs; const float* sgu;
    __device__ __forceinline__ void operator()(const pg8::i32x4 (&acc)[2][2][4][2], const Unit& u, int wr, int wc, int fr, int fq) const {
        const int row0 = u.pm * 256 + wr * 64 + fr, col0 = u.pn * 128 + wc * 32 + 8 * fq;
        const float* sp = sgu + (size_t)(u.aux * 22 + u.pn) * 256 + wc * 32 + 8 * fq;
        const f32x4 sg0 = *(const f32x4*)sp, sg1 = *(const f32x4*)(sp + 4), su0 = *(const f32x4*)(sp + 128), su1 = *(const f32x4*)(sp + 132);
#pragma unroll
        for (int ai = 0; ai < 2; ++ai)
#pragma unroll
            for (int m = 0; m < 4; ++m) { const int row = row0 + ai * 128 + m * 16; const float xr = xs[row]; unsigned char* rowp = ACT + (size_t)row * FF + col0;
                const pg8::i32x4 gi0 = acc[ai][0][m][0], gi1 = acc[ai][0][m][1], ui0 = acc[ai][1][m][0], ui1 = acc[ai][1][m][1];
                const f32x4 g0 = {(float)gi0[0], (float)gi0[1], (float)gi0[2], (float)gi0[3]}, g1 = {(float)gi1[0], (float)gi1[1], (float)gi1[2], (float)gi1[3]};
                const f32x4 u0 = {(float)ui0[0], (float)ui0[1], (float)ui0[2], (float)ui0[3]}, u1 = {(float)ui1[0], (float)ui1[1], (float)ui1[2], (float)ui1[3]};
                const f32x4 a0 = g0 * sg0 * xr, a1 = g1 * sg1 * xr, b0 = u0 * su0 * xr, b1 = u1 * su1 * xr; v2u w; unsigned t = 0u;
                t = __builtin_amdgcn_cvt_pk_fp8_f32(a0[0] * sigmoid_f(a0[0]) * b0[0], a0[1] * sigmoid_f(a0[1]) * b0[1], t, false); t = __builtin_amdgcn_cvt_pk_fp8_f32(a0[2] * sigmoid_f(a0[2]) * b0[2], a0[3] * sigmoid_f(a0[3]) * b0[3], t, true); w.x = t;
                t = __builtin_amdgcn_cvt_pk_fp8_f32(a1[0] * sigmoid_f(a1[0]) * b1[0], a1[1] * sigmoid_f(a1[1]) * b1[1], t, false); t = __builtin_amdgcn_cvt_pk_fp8_f32(a1[2] * sigmoid_f(a1[2]) * b1[2], a1[3] * sigmoid_f(a1[3]) * b1[3], t, true); w.y = t;
                *(v2u*)rowp = w; }
    }
};
constexpr float Y_SCALE = 16.0f;
struct EpiDown {
    bf16_t* Y; const float* selw; const float* wsc;
    __device__ __forceinline__ void operator()(const f32x4 (&acc)[2][2][4][2], const Unit& u, int wr, int wc, int fr, int fq) const {
        const int row0 = u.pm * 256 + wr * 64 + fr, col0 = u.pn * 256 + wc * 32 + 8 * fq; const float* cp = wsc + (size_t)u.aux * D + col0; f32x4 cs[2][2];
#pragma unroll
        for (int bj = 0; bj < 2; ++bj) { cs[bj][0] = *(const f32x4*)(cp + bj * 128); cs[bj][1] = *(const f32x4*)(cp + bj * 128 + 4); }
#pragma unroll
        for (int ai = 0; ai < 2; ++ai)
#pragma unroll
            for (int m = 0; m < 4; ++m) { const int row = row0 + ai * 128 + m * 16; const float wv = selw[row] * Y_SCALE; unsigned char* rowp = (unsigned char*)Y + (size_t)row * D + col0;
#pragma unroll
                for (int bj = 0; bj < 2; ++bj) { const f32x4 v0 = acc[ai][bj][m][0] * cs[bj][0] * wv, v1 = acc[ai][bj][m][1] * cs[bj][1] * wv; v2u w; unsigned t = 0u;
#define YC(x) __builtin_amdgcn_fmed3f((x), -448.0f, 448.0f)
                    t = __builtin_amdgcn_cvt_pk_fp8_f32(YC(v0[0]), YC(v0[1]), t, false); t = __builtin_amdgcn_cvt_pk_fp8_f32(YC(v0[2]), YC(v0[3]), t, true); w.x = t;
                    t = __builtin_amdgcn_cvt_pk_fp8_f32(YC(v1[0]), YC(v1[1]), t, false); t = __builtin_amdgcn_cvt_pk_fp8_f32(YC(v1[2]), YC(v1[3]), t, true); w.y = t;
#undef YC
                    *(v2u*)(rowp + bj * 128) = w; } }
    }
};

struct SchedGrid {
    const char* A; const char* B; size_t tstep; int nM, nN, G, c;
    __device__ __forceinline__ bool next(int i, Unit& u) const { const long L = (long)i * G + c; if (L >= (long)nM * nN) return false;
        int pm, pn; pg8::tile_of((int)L, nM, nN, pm, pn); u.pm = pm; u.pn = pn; u.aux = 0; u.idx = nullptr; u.a = A + (size_t)pm * tstep; u.b = B + (size_t)pn * tstep; return true; }
};
struct SchedGridMap {
    const char* A; const char* B; size_t tstep; int nM, nN, G, c, split, ofs0, ofs1;
    __device__ __forceinline__ bool next(int i, Unit& u) const { const long L = (long)i * G + c; if (L >= (long)nM * nN) return false;
        int pm, pj; pg8::tile_of((int)L, nM, nN, pm, pj); const int pn = pj < split ? pj + ofs0 : pj + ofs1; u.pm = pm; u.pn = pn; u.aux = 0; u.a = A + (size_t)pm * tstep; u.b = B + (size_t)pn * tstep; return true; }
};
struct SchedPair {
    const char *A0, *A1, *B0, *B1; size_t tstep; int nM, nN, G, c;
    __device__ __forceinline__ bool next(int i, Unit& u) const { const long L = (long)(i >> 1) * G + c; if (L >= (long)nM * nN) return false;
        int pm, pn; pg8::tile_of((int)L, nM, nN, pm, pn); u.pm = pm; u.pn = pn; u.aux = i & 1;
        u.a = ((i & 1) ? A1 : A0) + (size_t)pm * tstep; u.b = ((i & 1) ? B1 : B0) + (size_t)pn * tstep; return true; }
};
struct SchedMoe {
    const char* A; const char* B; size_t atstep, btstep; int NT, G, c; const int* idx;
    __device__ __forceinline__ bool next(int i, Unit& u) const { const long L = (long)i * G + c; const int per = 24 * NT; if (L >= (long)NE * per) return false;
        const int e = (int)(L / per), r = (int)(L % per), mt = r % 24, nt = r / 24;
        const int pm = mt < 8 ? e * 8 + mt : 128 + e * 16 + (mt - 8);
        u.pm = pm; u.pn = nt; u.aux = e; u.idx = idx ? idx + pm * 256 : nullptr; u.a = idx ? A : A + (size_t)pm * atstep; u.b = B + (size_t)(e * NT + nt) * btstep; return true; }
};

typedef short bf16x8_t __attribute__((ext_vector_type(8)));
typedef short s16x4_t __attribute__((ext_vector_type(4)));
typedef float f32x16 __attribute__((ext_vector_type(16)));
typedef float f32x2_t __attribute__((ext_vector_type(2)));
typedef __bf16 bf16x2_t __attribute__((ext_vector_type(2)));
__device__ __forceinline__ unsigned cvt2(float lo, float hi) { const f32x2_t v = {lo, hi}; const bf16x2_t b2 = __builtin_convertvector(v, bf16x2_t); return __builtin_bit_cast(unsigned, b2); }
constexpr int AT_KS = 272, AT_VS = 320, AT_KB = 64 * AT_KS, AT_VB = 64 * AT_VS, AT_BUF = AT_KB + AT_VB;
constexpr int AT_GQK = AUX_OFF;
__device__ __forceinline__ void attn_unit(const Frame& F, int qb, int hk) {
    const int lane = F.lane, tid = F.tid, w = F.wave, g = w >> 1, j = w & 1, c = lane & 31, h = lane >> 5, l15 = lane & 15, grp = (lane >> 4) & 1;
    const int R0 = qb * 64, s = seq_of(R0), t0 = seq_start(s), L = seq_len(s), P0 = R0 - t0, head = 4 * hk + g;
    bf16* Qb = (bf16*)(F.ws + WS_Q); const bf16* Kb = (const bf16*)((unsigned char*)F.out + DO_K); const bf16* Vb = (const bf16*)((unsigned char*)F.out + DO_V);
    const LAS float* gqk = (const LAS float*)(F.lds + AT_GQK);
    constexpr float LOG2E = 1.4426950408889634f;
    float gmax = fmaxf(fabsf(gqk[lane]), fabsf(gqk[lane + 64])); gmax = wave_max(gmax);
    const float sinkv = F.in[11][head];
    const float M2 = fmaxf(11.313708499f * gmax, sinkv) * LOG2E, slope2 = exp2f(-0.5f * (float)(head + 1)) * LOG2E;
    bf16x8_t qf[8];
    { const bf16* qrow = Qb + (size_t)(R0 + 32 * j + c) * D + head * 128 + 8 * h;
#pragma unroll
      for (int ks = 0; ks < 8; ++ks) qf[ks] = __builtin_bit_cast(bf16x8_t, *(const v4u*)(qrow + 16 * ks)); }
    f32x16 o[4];
#pragma unroll
    for (int dt = 0; dt < 4; ++dt)
#pragma unroll
        for (int i = 0; i < 16; ++i) o[dt][i] = 0.f;
    float lsum = 0.f;
    const int c_lo = P0 >= 128 ? 0 : (P0 >= 64 ? 1 : 2), c_hi = (P0 + 192 <= L) ? 4 : ((P0 + 128 <= L) ? 3 : 2);
    LAS unsigned char* ring = F.lds + RING_OFF;
    v4u kr[2], vr[2];
#define AT_LOAD(cc) do { const int kp = P0 - 128 + 64 * (cc); _Pragma("unroll") for (int i = 0; i < 2; ++i) { const int p = tid + 512 * i; const size_t off = (size_t)(t0 + kp + (p >> 4)) * KVW + hk * 128 + (p & 15) * 8; \
        kr[i] = *(const v4u*)(Kb + off); vr[i] = *(const v4u*)(Vb + off); } } while (0)
#define AT_WRITE(bufi) do { LAS unsigned char* kb_ = ring + (bufi) * AT_BUF; LAS unsigned char* vb_ = kb_ + AT_KB; _Pragma("unroll") for (int i = 0; i < 2; ++i) { const int p = tid + 512 * i, key = p >> 4, dd = (p & 15) * 8; \
        *(LAS v4u*)(kb_ + key * AT_KS + dd * 2) = kr[i]; *(LAS v4u*)(vb_ + key * AT_VS + dd * 2) = vr[i]; } } while (0)
    AT_LOAD(c_lo); AT_WRITE(0);
    __syncthreads();
    for (int cc = c_lo; cc <= c_hi; ++cc) {
        const int bi = (cc - c_lo) & 1;
        if (cc < c_hi) AT_LOAD(cc + 1);
        const LAS unsigned char* kbuf = ring + bi * AT_BUF; const LAS unsigned char* vbuf = kbuf + AT_KB;
#pragma unroll
        for (int u = 0; u < 2; ++u) {
            const int tt = 2 * cc + u;
            if (tt >= j && tt <= j + 8) {
                const int d0 = -128 + 32 * (tt - j);
                f32x16 sacc;
#pragma unroll
                for (int i = 0; i < 16; ++i) sacc[i] = 0.f;
#pragma unroll
                for (int ks = 0; ks < 8; ++ks) { const bf16x8_t kf = *(const LAS bf16x8_t*)(kbuf + (32 * u + c) * AT_KS + (16 * ks + 8 * h) * 2);
                    sacc = __builtin_amdgcn_mfma_f32_32x32x16_bf16(kf, qf[ks], sacc, 0, 0, 0); }
                const float relb = (float)(d0 - c + 4 * h); const int keyb = 4 * h;
                unsigned pk[8];
#pragma unroll
                for (int i2 = 0; i2 < 8; ++i2) { float pe[2];
#pragma unroll
                    for (int q = 0; q < 2; ++q) { const int i = 2 * i2 + q, ko = (i & 3) + 8 * (i >> 2);
                        float v = __builtin_amdgcn_exp2f(sacc[i] - slope2 * fabsf(relb + (float)ko) - M2);
                        if (d0 == -128) v = (keyb + ko >= c) ? v : 0.f;
                        if (d0 == 128) v = (keyb + ko <= c) ? v : 0.f;
                        lsum += v; pe[q] = v; }
                    pk[i2] = cvt2(pe[0], pe[1]); }
                const bf16x8_t pf0 = __builtin_bit_cast(bf16x8_t, (v4u){pk[0], pk[1], pk[2], pk[3]}), pf1 = __builtin_bit_cast(bf16x8_t, (v4u){pk[4], pk[5], pk[6], pk[7]});
                const LAS unsigned char* vrow = vbuf + (32 * u + 4 * h + (l15 >> 2)) * AT_VS + (16 * grp) * 2 + (l15 & 3) * 8;
#pragma unroll
                for (int dt = 0; dt < 4; ++dt) {
#pragma unroll
                    for (int sx = 0; sx < 2; ++sx) { const LAS unsigned char* vp = vrow + (16 * sx) * AT_VS + dt * 64;
                        const s16x4_t lo = __builtin_bit_cast(s16x4_t, __builtin_amdgcn_ds_read_tr16_b64_v4i16((LAS s16x4_t*)vp));
                        const s16x4_t hi = __builtin_bit_cast(s16x4_t, __builtin_amdgcn_ds_read_tr16_b64_v4i16((LAS s16x4_t*)(vp + 8 * AT_VS)));
                        const bf16x8_t vf = {lo[0], lo[1], lo[2], lo[3], hi[0], hi[1], hi[2], hi[3]};
                        o[dt] = __builtin_amdgcn_mfma_f32_32x32x16_bf16(vf, sx ? pf1 : pf0, o[dt], 0, 0, 0); } }
            }
        }
        if (cc < c_hi) AT_WRITE(bi ^ 1);
        __syncthreads();
    }
#undef AT_LOAD
#undef AT_WRITE
    lsum += __shfl_xor(lsum, 32);
    const float inv = 1.0f / (lsum + __builtin_amdgcn_exp2f(sinkv * LOG2E - M2));
    unsigned char* orow = F.ws + WS_ATT8 + (size_t)(R0 + 32 * j + c) * D + head * 128 + 4 * h;
#pragma unroll
    for (int dt = 0; dt < 4; ++dt)
#pragma unroll
        for (int gi = 0; gi < 4; ++gi) { unsigned t = 0u; t = __builtin_amdgcn_cvt_pk_fp8_f32(o[dt][4 * gi] * inv, o[dt][4 * gi + 1] * inv, t, false); t = __builtin_amdgcn_cvt_pk_fp8_f32(o[dt][4 * gi + 2] * inv, o[dt][4 * gi + 3] * inv, t, true);
            *(unsigned*)(orow + 32 * dt + 8 * gi) = t; }
}
constexpr int SG_VS = 320, SG_WS = 272, SG_MS = 272, SG_VN = 0, SG_W = 128 * SG_VS, SG_MIX = SG_W + 128 * SG_WS;
__device__ __forceinline__ f32x4 i8x4_f32(unsigned w) { return (f32x4){(float)(int)(signed char)(w & 255u), (float)(int)(signed char)((w >> 8) & 255u), (float)(int)(signed char)((w >> 16) & 255u), (float)((int)w >> 24)}; }
__device__ __forceinline__ void sgu_unit(const Frame& F, int chunk, int gquad) {
    LAS unsigned char* ring = F.lds + RING_OFF;
    LAS float* st = (LAS float*)(F.lds + AUX_OFF + 1024);
    bf16* U = (bf16*)(F.ws + WS_U); const unsigned char* VG8 = F.ws + WS_VG8; const unsigned char* U8 = F.ws + WS_U8; const float* VSc = (const float*)(F.ws + WS_VS); const float* USc = (const float*)(F.ws + WS_US); const bf16* SW = (const bf16*)(F.ws + WS_SGW);
    const float* vst = (const float*)((unsigned char*)F.out + DO_VST);
    const float* lng = F.in[12]; const float* lnb = F.in[13]; const float* sb = F.in[15];
    const int row0 = chunk * 128, tid = F.tid, lane = F.lane, w = F.wave, c31 = lane & 31, h = lane >> 5, l15 = lane & 15, grp = (lane >> 4) & 1;
    { const int r = tid >> 2, q = tid & 3; const f32x4* p = (const f32x4*)(vst + ((size_t)(row0 + r) * 32 + q * 8) * 2); float s1 = 0.f, s2 = 0.f;
#pragma unroll
      for (int i = 0; i < 4; ++i) { const f32x4 x = p[i]; s1 += x.x + x.z; s2 += x.y + x.w; }
      s1 += __shfl_xor(s1, 1); s1 += __shfl_xor(s1, 2); s2 += __shfl_xor(s2, 1); s2 += __shfl_xor(s2, 2);
      const float mean = s1 * (1.0f / D), var = fmaxf(s2 * (1.0f / D) - mean * mean, 0.f);
      if (q == 0) { st[2 * r] = mean; st[2 * r + 1] = 1.0f / sqrtf(var + NORM_EPS); } }
    __syncthreads();
    const int sr = tid >> 4, sc = (tid & 15) * 8;
    const int ct = w & 3, th = w >> 2;
    for (int gi = 0; gi < 4; ++gi) {
        const int g = gquad * 4 + gi;
        v2u xv[4], uv[4]; v4u wv[4]; float vsc[4], usc[4];
#pragma unroll
        for (int q = 0; q < 4; ++q) { const int r = sr + 32 * q; xv[q] = *(const v2u*)(VG8 + (size_t)(row0 + r) * D + g * 128 + sc); wv[q] = *(const v4u*)(SW + (size_t)g * 16384 + r * 128 + sc);
            uv[q] = *(const v2u*)(U8 + (size_t)(row0 + r) * D + g * 128 + sc); vsc[q] = VSc[(size_t)(row0 + r) * 8 + (g >> 1)]; usc[q] = USc[(size_t)(row0 + r) * 8 + (g >> 1)]; }
        { const f32x4 ga = *(const f32x4*)(lng + g * 128 + sc), gb = *(const f32x4*)(lng + g * 128 + sc + 4), ba = *(const f32x4*)(lnb + g * 128 + sc), bb = *(const f32x4*)(lnb + g * 128 + sc + 4);
#pragma unroll
          for (int q = 0; q < 4; ++q) { const int r = sr + 32 * q; const float mean = st[2 * r], rstd = st[2 * r + 1]; const v2u x = xv[q];
              const f32x4 fa = i8x4_f32(x.x) * vsc[q], fb = i8x4_f32(x.y) * vsc[q];
              const f32x4 ya = (fa - mean) * rstd * ga + ba, yb = (fb - mean) * rstd * gb + bb;
              v4u o; o.x = cvt2(ya.x, ya.y); o.y = cvt2(ya.z, ya.w); o.z = cvt2(yb.x, yb.y); o.w = cvt2(yb.z, yb.w);
              *(LAS v4u*)(ring + SG_VN + r * SG_VS + sc * 2) = o; *(LAS v4u*)(ring + SG_W + r * SG_WS + sc * 2) = wv[q]; } }
        __syncthreads();
        f32x16 acc[2];
#pragma unroll
        for (int x = 0; x < 2; ++x)
#pragma unroll
            for (int i = 0; i < 16; ++i) acc[x][i] = 0.f;
        { const LAS unsigned char* vrow = ring + SG_VN + (8 * h + (l15 >> 2)) * SG_VS + (32 * ct + 16 * grp) * 2 + (l15 & 3) * 8;
          const LAS unsigned char* wrow = ring + SG_W + (64 * th + c31) * SG_WS + (8 * h) * 2;
#pragma unroll
          for (int ks = 0; ks < 8; ++ks) {
              const s16x4_t lo = __builtin_bit_cast(s16x4_t, __builtin_amdgcn_ds_read_tr16_b64_v4i16((LAS s16x4_t*)(vrow + (16 * ks) * SG_VS)));
              const s16x4_t hi = __builtin_bit_cast(s16x4_t, __builtin_amdgcn_ds_read_tr16_b64_v4i16((LAS s16x4_t*)(vrow + (16 * ks + 4) * SG_VS)));
              const bf16x8_t af = {lo[0], lo[1], lo[2], lo[3], hi[0], hi[1], hi[2], hi[3]};
#pragma unroll
              for (int x = 0; x < 2; ++x) { const bf16x8_t bfr = *(const LAS bf16x8_t*)(wrow + (32 * x) * SG_WS + (16 * ks) * 2);
                  acc[x] = __builtin_amdgcn_mfma_f32_32x32x16_bf16(af, bfr, acc[x], 0, 0, 0); } } }
#pragma unroll
        for (int x = 0; x < 2; ++x) { const int t = 64 * th + 32 * x + c31; const float bias = sb[g * 128 + t];
#pragma unroll
            for (int q4 = 0; q4 < 4; ++q4) { v2u o; o.x = cvt2(acc[x][4 * q4] + bias, acc[x][4 * q4 + 1] + bias); o.y = cvt2(acc[x][4 * q4 + 2] + bias, acc[x][4 * q4 + 3] + bias);
                *(LAS v2u*)(ring + SG_MIX + t * SG_MS + (32 * ct + 8 * q4 + 4 * h) * 2) = o; } }
        __syncthreads();
#pragma unroll
        for (int q = 0; q < 4; ++q) { const int r = sr + 32 * q; const v4u m8 = *(const LAS v4u*)(ring + SG_MIX + r * SG_MS + sc * 2); const f32x4 ua = i8x4_f32(uv[q].x) * usc[q], ub = i8x4_f32(uv[q].y) * usc[q]; v4u o;
            o.x = cvt2(ua.x * bf_lo(m8.x), ua.y * bf_hi(m8.x)); o.y = cvt2(ua.z * bf_lo(m8.y), ua.w * bf_hi(m8.y));
            o.z = cvt2(ub.x * bf_lo(m8.z), ub.y * bf_hi(m8.z)); o.w = cvt2(ub.z * bf_lo(m8.w), ub.w * bf_hi(m8.w));
            *(v4u*)(U + (size_t)(row0 + r) * D + g * 128 + sc) = o; }
    }
    __syncthreads();
}

template <int PER> __device__ __forceinline__ void topk_body(const Frame& F, int g, int e) {
    constexpr int T = PER * 512, C = T / 8; const int tid = F.tid, lane = F.lane, w = F.wave;
    const float* vals = (const float*)(F.ws + WS_AFFT) + (g ? (size_t)NE * TP + (size_t)e * TS : (size_t)e * TP);
    LAS unsigned* lv = (LAS unsigned*)(F.lds + RING_OFF);
    LAS unsigned* red = (LAS unsigned*)(F.lds + AUX_OFF + 8192);
    LAS unsigned* cg = red + 64; LAS unsigned* ce = red + 64 + 520;
    for (int i = tid; i < T; i += 512) lv[i + (i >> 5)] = __float_as_uint(vals[i]);
    __syncthreads();
    unsigned v[PER]; const int i0 = tid * PER;
#pragma unroll
    for (int i = 0; i < PER; ++i) v[i] = lv[i0 + i + ((i0 + i) >> 5)];
    unsigned prefix = 0u;
    for (int bit = 30; bit >= 0; --bit) {
        const unsigned cand = prefix | (1u << bit); unsigned cnt = 0u;
#pragma unroll
        for (int i = 0; i < PER; ++i) cnt += (v[i] >= cand) ? 1u : 0u;
        cnt = (unsigned)wave_sum_i((int)cnt);
        LAS unsigned* rb = red + (bit & 1) * 8;
        if (lane == 0) rb[w] = cnt;
        __syncthreads();
        const unsigned tot = (rb[0] + rb[1]) + (rb[2] + rb[3]) + ((rb[4] + rb[5]) + (rb[6] + rb[7]));
        if (tot >= (unsigned)C) prefix = cand;
    }
    const unsigned thr = prefix;
    unsigned ng = 0u, ne = 0u;
#pragma unroll
    for (int i = 0; i < PER; ++i) { ng += (v[i] > thr) ? 1u : 0u; ne += (v[i] == thr) ? 1u : 0u; }
    __syncthreads();
    cg[tid] = ng; ce[tid] = ne;
    __syncthreads();
    if (w == 0) {
        unsigned a[8], b[8], sa = 0u, sb2 = 0u;
#pragma unroll
        for (int i = 0; i < 8; ++i) { a[i] = cg[lane * 8 + i]; b[i] = ce[lane * 8 + i]; sa += a[i]; sb2 += b[i]; }
        unsigned pa = sa, pb = sb2;
#pragma unroll
        for (int o = 1; o < 64; o <<= 1) { const unsigned ta = __shfl_up(pa, o), tb = __shfl_up(pb, o); if (lane >= o) { pa += ta; pb += tb; } }
        unsigned ea = pa - sa, eb = pb - sb2;
#pragma unroll
        for (int i = 0; i < 8; ++i) { cg[lane * 8 + i] = ea; ce[lane * 8 + i] = eb; ea += a[i]; eb += b[i]; }
        if (lane == 63) { cg[512] = pa; }
    }
    __syncthreads();
    unsigned gb = cg[tid], eb = ce[tid]; const unsigned k = (unsigned)C - cg[512];
    int* seli = (int*)(F.ws + WS_SELI); float* selw = (float*)(F.ws + WS_SELW); int* inv = (int*)(F.ws + WS_INV); const float* hs = (const float*)(F.ws + WS_HS); float* xs = (float*)(F.ws + WS_XS);
    const int sbase = g ? NE * CAP_P + e * CAP_S : e * CAP_P, rbase = g ? TP : 0;
#pragma unroll 1
    for (int i = 0; i < PER; ++i) { const unsigned u = lv[i0 + i + ((i0 + i) >> 5)]; const int row = rbase + i0 + i; int slot = -1;
        if (u > thr) { slot = (int)(gb + (eb < k ? eb : k)); ++gb; }
        else if (u == thr) { if (eb < k) slot = (int)(gb + eb); ++eb; }
        inv[(size_t)row * NE + e] = slot;
        if (slot >= 0) { seli[sbase + slot] = row; selw[sbase + slot] = __uint_as_float(u); xs[sbase + slot] = hs[row]; } }
    __syncthreads();
}
__device__ __forceinline__ void topk_task(const Frame& F, int task) {
    const int g = task >> 4, e = task & 15;
    if (g) topk_body<TS / 512>(F, 1, e); else topk_body<TP / 512>(F, 0, e);
}

__global__ void __launch_bounds__(NWAVES * 64, 2) fwd_kernel(Args args) {
    extern __shared__ __attribute__((aligned(16))) unsigned char lds[];
    Frame F;
    F.lds = (LAS unsigned char*)lds;
    F.tid = threadIdx.x; F.lane = F.tid & 63; F.wave = __builtin_amdgcn_readfirstlane(F.tid >> 6);
    F.G = gridDim.x; { const int bx = blockIdx.x; F.vcu = (F.G % 8 == 0) ? (bx % 8) * (F.G / 8) + bx / 8 : bx; }
    F.in = args.in; F.out = args.out; F.ws = args.ws;
    volatile LAS unsigned* MISC = (volatile LAS unsigned*)(F.lds + MISC_OFF);
    if (F.tid < 64) MISC[F.tid] = 0u;
    __syncthreads();
    unsigned* ctl = (unsigned*)(F.ws + WS_CTL);
    XcdBarrier bar; bar.bar = ctl + CW_BAR; bar.x = 0; bar.st = nullptr; bar.wave = F.wave;
    if (!MK_PER_PHASE) bar = xcd_barrier_post(ctl + CW_BAR, MISC + 8);
    const int lo = args.ph_lo, hi = args.ph_hi;
#define IN(k) (lo <= (k) && (k) < hi)
#define REPS(k) (((PROBE_MASK >> (k)) & 1) ? 2 : 1)
#define SEAM(k) do { if (IN(k) && IN((k) + 1)) xcd_barrier(bar); } while (0)
    const int gw = F.vcu * NWAVES + F.wave, NGW = F.G * NWAVES;
    unsigned char* const ws = F.ws; unsigned char* const ob = (unsigned char*)F.out;

    if (IN(0)) { for (int rep = 0; rep < REPS(0); ++rep) p0_prologue(F); } SEAM(0);
    F.lane = fresh_lane(); F.tid = F.lane + (F.wave << 6);
    if (IN(1)) { for (int rep = 0; rep < REPS(1); ++rep) p1_rows(F); } SEAM(1);
    if (IN(2)) {
        SchedGrid S{(const char*)(ws + WS_H1Q), (const char*)(ws + WS_WIN8), (size_t)256 * D, M / 256, IN_W / 256, F.G, (int)blockIdx.x};
        EpiGate E{(bf16_t*)(ws + WS_Q), (bf16_t*)(ob + DO_K), (bf16_t*)(ob + DO_V), (bf16_t*)(ws + WS_U8), (bf16_t*)(ws + WS_VG8), (bf16_t*)(ws + WS_GS), (bf16_t*)(ws + WS_GS + (size_t)M * D), (float*)(ob + DO_VST), (const float*)(ws + WS_HS1), (const float*)(ws + WS_SWIN), F.in[9], F.in[10], (LAS float*)(F.lds + AUX_OFF), (float*)(ws + WS_US), (float*)(ws + WS_VS)};
        pg8::gemm_phase<EpiGate, SchedGrid, true, true, 1>(F.lds + RING_OFF, D, D, D / 128, S, E, F.wave);
    } SEAM(2);
    F.lane = fresh_lane(); F.tid = F.lane + (F.wave << 6);
    if (IN(3)) {
        for (int n = F.vcu; n < (M / 128) * 4; n += F.G) sgu_unit(F, n >> 2, n & 3);
        if (F.tid < 128) ((LAS float*)(F.lds + AT_GQK))[F.tid] = F.in[9][F.tid] * F.in[10][F.tid];
        __syncthreads();
        for (int n = F.vcu; n < (M / 64) * 4; n += F.G) attn_unit(F, n >> 2, n & 3);
    } SEAM(3);
    if (IN(4)) {
        { SchedGrid S{(const char*)(ws + WS_ATT8), (const char*)(ws + WS_WOA8), (size_t)256 * D, M / 256, D / 256, F.G, (int)blockIdx.x};
          EpiMerge E{(bf16_t*)(ws + WS_GA), ws + WS_GS, (const float*)(ws + WS_WSCO), 0};
          pg8::gemm_phase<EpiMerge, SchedGrid, true, true, 2>(F.lds + RING_OFF, D, D, D / 128, S, E, F.wave); }
        { SchedGrid S{(const char*)(ws + WS_U), (const char*)(ws + WS_WOS), (size_t)256 * D * 2, M / 256, D / 256, F.G, (int)blockIdx.x};
          EpiMerge E{(bf16_t*)(ws + WS_GA), ws + WS_GS + (size_t)M * D, (const float*)(ws + WS_WSCO), 1};
          pg8::gemm_phase<EpiMerge, SchedGrid, true, true>(F.lds + RING_OFF, D * 2, D * 2, D / 64, S, E, F.wave); }
    } SEAM(4);
    F.lane = fresh_lane(); F.tid = F.lane + (F.wave << 6);
    if (IN(5)) {
        const bf16* mg = (const bf16*)(ws + WS_GA); unsigned* mq = (unsigned*)(ws + WS_MQ); float* msc = (float*)(ws + WS_MS);
        for (int m = gw; m < M; m += NGW) { const v4u* src = (const v4u*)(mg + (size_t)m * D) + F.lane; v4u x[4]; float amax = 0.f;
#pragma unroll
            for (int j = 0; j < 4; ++j) { x[j] = src[64 * j];
                amax = fmaxf(amax, fmaxf(fmaxf(fmaxf(fabsf(bf_lo(x[j].x)), fabsf(bf_hi(x[j].x))), fmaxf(fabsf(bf_lo(x[j].y)), fabsf(bf_hi(x[j].y)))), fmaxf(fmaxf(fabsf(bf_lo(x[j].z)), fabsf(bf_hi(x[j].z))), fmaxf(fabsf(bf_lo(x[j].w)), fabsf(bf_hi(x[j].w)))))); }
            amax = wave_max(amax); const float inv = amax > 0.f ? 127.0f / amax : 0.f; v2u* dst = (v2u*)(mq + (size_t)m * (D / 4)) + F.lane;
#pragma unroll
            for (int j = 0; j < 4; ++j) { v2u o; o.x = q8x4(bf_lo(x[j].x), bf_hi(x[j].x), bf_lo(x[j].y), bf_hi(x[j].y), inv); o.y = q8x4(bf_lo(x[j].z), bf_hi(x[j].z), bf_lo(x[j].w), bf_hi(x[j].w), inv); dst[64 * j] = o; }
            if (F.lane == 0) msc[m] = amax * (1.0f / 127.0f); }
        if (!MK_PER_PHASE) xcd_barrier(bar);
    }
    if (IN(5)) {
        SchedGrid S{(const char*)(ws + WS_MQ), (const char*)(ws + WS_WOUT), (size_t)256 * D, M / 256, D / 256, F.G, (int)blockIdx.x};
        EpiOut E{F.in[0], F.in[1], F.out, (const float*)(ws + WS_MOD), (const float*)(ws + WS_MS), (const float*)(ws + WS_SWO)};
        pg8::gemm_phase<EpiOut, SchedGrid, true, true, 1>(F.lds + RING_OFF, D, D, D / 128, S, E, F.wave);
    } SEAM(5);
    F.lane = fresh_lane(); F.tid = F.lane + (F.wave << 6);
    if (IN(6)) { for (int rep = 0; rep < REPS(6); ++rep) p6_rows(F); } SEAM(6);
    F.lane = fresh_lane(); F.tid = F.lane + (F.wave << 6);
    if (IN(7)) for (int rep = 0; rep < REPS(7); ++rep) { for (int task = blockIdx.x; task < 2 * NE; task += F.G) topk_task(F, task); } SEAM(7);
    if (IN(9)) {
        SchedMoe S{(const char*)(ws + WS_Q), (const char*)(ws + WS_WGU), (size_t)256 * D, (size_t)256 * D, FF / 128, F.G, (int)blockIdx.x, (const int*)(ws + WS_SELI)};
        EpiGU E{ws + WS_ACT, (const float*)(ws + WS_XS), (const float*)(ws + WS_SGU)};
        pg8::gemm_phase<EpiGU, SchedMoe, true, true, 1, true>(F.lds + RING_OFF, D, D, D / 128, S, E, F.wave);
    }
    if (IN(9) && REPS(9) == 2) {
        SchedMoe S{(const char*)(ws + WS_Q), (const char*)(ws + WS_WGU), (size_t)256 * D, (size_t)256 * D, FF / 128, F.G, (int)blockIdx.x, (const int*)(ws + WS_SELI)};
        EpiGU E{ws + WS_ACT, (const float*)(ws + WS_XS), (const float*)(ws + WS_SGU)};
        pg8::gemm_phase<EpiGU, SchedMoe, true, true, 1, true>(F.lds + RING_OFF, D, D, D / 128, S, E, F.wave);
    } SEAM(9);
    if (IN(10)) {
        SchedMoe S{(const char*)(ws + WS_ACT), (const char*)(ws + WS_WD), (size_t)256 * FF, (size_t)256 * FF, D / 256, F.G, (int)blockIdx.x, nullptr};
        EpiDown E{(bf16_t*)(ws + WS_XE), (const float*)(ws + WS_SELW), (const float*)(ws + WS_WSC)};
        pg8::gemm_phase<EpiDown, SchedMoe, true, true, 2>(F.lds + RING_OFF, FF, FF, FF / 128, S, E, F.wave);
    }
    if (IN(10) && REPS(10) == 2) {
        SchedMoe S{(const char*)(ws + WS_ACT), (const char*)(ws + WS_WD), (size_t)256 * FF, (size_t)256 * FF, D / 256, F.G, (int)blockIdx.x, nullptr};
        EpiDown E{(bf16_t*)(ws + WS_XE), (const float*)(ws + WS_SELW), (const float*)(ws + WS_WSC)};
        pg8::gemm_phase<EpiDown, SchedMoe, true, true, 2>(F.lds + RING_OFF, FF, FF, FF / 128, S, E, F.wave);
    } SEAM(10);
    F.lane = fresh_lane(); F.tid = F.lane + (F.wave << 6);
    if (IN(11)) {
        const int* inv = (const int*)(ws + WS_INV); const unsigned char* Y = (const unsigned char*)(ws + WS_XE); const float* mod = (const float*)(ws + WS_MOD);
        for (int m = gw; m < M; m += NGW) {
            const int s = seq_of(m), g = m < TP ? 0 : 1; const int myinv = inv[(size_t)m * NE + (F.lane & 15)];
            f32x4* op = (f32x4*)(F.out + (size_t)m * D) + F.lane; f32x4 acc[8], xv[8];
#pragma unroll
            for (int j = 0; j < 8; ++j) { acc[j] = (f32x4){0.f, 0.f, 0.f, 0.f}; xv[j] = op[64 * j]; }
            unsigned emask = (unsigned)(__ballot(myinv >= 0) & 0xFFFFull);
            while (emask) {
                const int e1 = __ffs(emask) - 1; emask &= emask - 1; const bool two = emask != 0u; const int e2 = two ? __ffs(emask) - 1 : e1; if (two) emask &= emask - 1;
                const int c1 = __shfl(myinv, e1), c2 = __shfl(myinv, e2);
                const size_t s1 = g ? (size_t)NE * CAP_P + (size_t)e1 * CAP_S + c1 : (size_t)e1 * CAP_P + c1, s2 = g ? (size_t)NE * CAP_P + (size_t)e2 * CAP_S + c2 : (size_t)e2 * CAP_P + c2;
                const unsigned* y1p = (const unsigned*)(Y + s1 * D) + F.lane; const unsigned* y2p = (const unsigned*)(Y + s2 * D) + F.lane; unsigned y1[8], y2[8];
#pragma unroll
                for (int j = 0; j < 8; ++j) { y1[j] = __builtin_nontemporal_load(&y1p[64 * j]); y2[j] = __builtin_nontemporal_load(&y2p[64 * j]); }
#pragma unroll
                for (int j = 0; j < 8; ++j) { typedef float f2_t __attribute__((ext_vector_type(2)));
                    { const f2_t lo = __builtin_amdgcn_cvt_pk_f32_fp8((int)y1[j], false), hi = __builtin_amdgcn_cvt_pk_f32_fp8((int)y1[j], true); acc[j] += (f32x4){lo.x, lo.y, hi.x, hi.y}; }
                    if (two) { const f2_t lo = __builtin_amdgcn_cvt_pk_f32_fp8((int)y2[j], false), hi = __builtin_amdgcn_cvt_pk_f32_fp8((int)y2[j], true); acc[j] += (f32x4){lo.x, lo.y, hi.x, hi.y}; } }
            }
            const f32x4* g2 = (const f32x4*)(mod + (size_t)s * MODW + 5 * D) + F.lane;
#pragma unroll
            for (int j = 0; j < 8; ++j) __builtin_nontemporal_store(xv[j] + g2[64 * j] * (1.0f / Y_SCALE) * acc[j], &op[64 * j]);
        }
    }
#undef IN
#undef SEAM
}


__global__ void dbg_dump(const unsigned short* q, const unsigned short* u, const unsigned short* vg, const unsigned short* ga, const unsigned short* gs, float* out, size_t n) {
    for (size_t i = (size_t)blockIdx.x * blockDim.x + threadIdx.x; i < n; i += (size_t)gridDim.x * blockDim.x) {
        out[i] = __uint_as_float((unsigned)q[i] << 16) + 2.f * __uint_as_float((unsigned)u[i] << 16) + 4.f * __uint_as_float((unsigned)vg[i] << 16) + 8.f * __uint_as_float((unsigned)ga[i] << 16) + 16.f * __uint_as_float((unsigned)gs[i] << 16); }
}

__global__ void dbg_dump2(const unsigned short* win, const unsigned short* wgu, const unsigned short* wd, const unsigned short* woa, float* out, size_t n) {
    for (size_t i = (size_t)blockIdx.x * blockDim.x + threadIdx.x; i < n; i += (size_t)gridDim.x * blockDim.x) {
        out[i] = __uint_as_float((unsigned)win[i % ((size_t)IN_W * D)] << 16) + 2.f * __uint_as_float((unsigned)wgu[i] << 16) + 4.f * __uint_as_float((unsigned)wd[i % ((size_t)NE * D * FF)] << 16) + 8.f * __uint_as_float((unsigned)woa[i % ((size_t)3 * D * D)] << 16); }
}

__device__ __forceinline__ float bf16r(float f) { unsigned u = __float_as_uint(f); u += 0x7fffu + ((u >> 16) & 1u); return __uint_as_float(u & 0xffff0000u); }
__global__ void dbg_check_gemm(const unsigned short* h1, const float* w_in, const unsigned short* Q, const unsigned short* Kb, const unsigned short* Vb, unsigned* cnt) {
    const int i = blockIdx.x * blockDim.x + threadIdx.x;
    unsigned long long z = (unsigned long long)i * 0x9E3779B97F4A7C15ull + 12345; z ^= z >> 29; z *= 0xBF58476D1CE4E5B9ull; z ^= z >> 32;
    const int m = (int)(z % M), n = (int)((z >> 20) % 3072);
    float ref = 0.f;
    for (int k = 0; k < D; ++k) ref += __uint_as_float((unsigned)h1[(size_t)m * D + k] << 16) * bf16r(w_in[(size_t)k * IN_W + n]);
    float got;
    if (n < 2048) got = __uint_as_float((unsigned)Q[(size_t)m * D + n] << 16);
    else if (n < 2560) got = __uint_as_float((unsigned)Kb[(size_t)m * KVW + n - 2048] << 16);
    else got = __uint_as_float((unsigned)Vb[(size_t)m * KVW + n - 2560] << 16);
    const float err = fabsf(got - ref);
    if (!(err <= 0.03f * (1.0f + fabsf(ref)))) { atomicAdd(cnt, 1u); if (n < 2048) atomicAdd(cnt + 1, 1u); else if (n < 2560) atomicAdd(cnt + 2, 1u); else atomicAdd(cnt + 3, 1u); if (fabsf(got) > 100.f) atomicAdd(cnt + 4, 1u); }
}
__global__ void dbg_fill(float* out, size_t n, const unsigned* cnt, int which) {
    const unsigned c = cnt[which]; const float v = c == 0 ? 0.f : c < 10 ? 1.f : c < 100 ? 2.f : c < 1000 ? 3.f : c < 10000 ? 4.f : 5.f;
    for (size_t i = (size_t)blockIdx.x * blockDim.x + threadIdx.x; i < n; i += (size_t)gridDim.x * blockDim.x) out[i] = v;
}
extern "C" void kernel_launch(void* const* d_in, const int* in_sizes, int n_in, void* d_out, int out_size, void* d_ws, size_t ws_size, hipStream_t stream) {
    static int grid = 0;
    if (grid == 0) {
        if (n_in != 23 || out_size != M * D || ws_size < WS_END) { fprintf(stderr, "kernel_launch: unexpected shapes (n_in %d, out %d, ws %zu, need %zu)\n", n_in, out_size, ws_size, (size_t)WS_END); grid = -1; return; }
        int dev = 0, cus = 0, per_cu = 0;
        if (hipGetDevice(&dev) != hipSuccess || hipDeviceGetAttribute(&cus, hipDeviceAttributeMultiprocessorCount, dev) != hipSuccess) { grid = -1; return; }
        if (hipFuncSetAttribute((const void*)fwd_kernel, hipFuncAttributeMaxDynamicSharedMemorySize, LDS_BYTES) != hipSuccess) { fprintf(stderr, "kernel_launch: hipFuncSetAttribute failed\n"); grid = -1; return; }
        if (hipOccupancyMaxActiveBlocksPerMultiprocessor(&per_cu, (const void*)fwd_kernel, NWAVES * 64, LDS_BYTES) != hipSuccess || per_cu < 1) fprintf(stderr, "kernel_launch: occupancy query says %d\n", per_cu);
        (void)hipGetLastError();
        grid = cus;
    }
    if (grid < 0) return;
    (void)hipMemsetAsync((char*)d_ws + WS_CTL, 0, CTL_ZERO_BYTES, stream);
    Args a{};
    for (int i = 0; i < 23; ++i) a.in[i] = (const float*)d_in[i];
    a.out = (float*)d_out; a.ws = (unsigned char*)d_ws;
#if MK_PER_PHASE
    for (int p = 0; p < DBG_NPH; ++p) { a.ph_lo = p; a.ph_hi = p + 1; a.li = p; hipLaunchKernelGGL(fwd_kernel, dim3(grid), dim3(NWAVES * 64), LDS_BYTES, stream, a); }
    if (DBG_NPH == 1) { unsigned char* w = (unsigned char*)d_ws; hipLaunchKernelGGL(dbg_dump2, dim3(4096), dim3(256), 0, stream, (const unsigned short*)(w + WS_WIN), (const unsigned short*)(w + WS_WGU), (const unsigned short*)(w + WS_WD), (const unsigned short*)(w + WS_WOA), (float*)d_out, (size_t)M * D); }
    else if (DBG_NPH == 3) { unsigned char* w = (unsigned char*)d_ws; unsigned* cnt = (unsigned*)(w + 512 * 1024);
        hipLaunchKernelGGL(dbg_check_gemm, dim3(256), dim3(256), 0, stream, (const unsigned short*)(w + WS_WGU), (const float*)d_in[8], (const unsigned short*)(w + WS_Q), (const unsigned short*)((unsigned char*)d_out + DO_K), (const unsigned short*)((unsigned char*)d_out + DO_V), cnt);
        hipLaunchKernelGGL(dbg_fill, dim3(4096), dim3(256), 0, stream, (float*)d_out, (size_t)M * D, (const unsigned*)cnt, DBG_WHICH); }
    else if (DBG_NPH < 6) { unsigned char* w = (unsigned char*)d_ws; hipLaunchKernelGGL(dbg_dump, dim3(4096), dim3(256), 0, stream, (const unsigned short*)(w + WS_Q), (const unsigned short*)(w + WS_U), (const unsigned short*)(w + WS_VG), (const unsigned short*)(w + WS_GA), (const unsigned short*)(w + WS_GS), (float*)d_out, (size_t)M * D); }
#else
    a.ph_lo = 0; a.ph_hi = NPHASE; a.li = 0; hipLaunchKernelGGL(fwd_kernel, dim3(grid), dim3(NWAVES * 64), LDS_BYTES, stream, a);
#endif
}
```
